# Optimizing an MI355X kernel written in HIP

```python
import math
import jax
import jax.numpy as jnp
from jax import lax
import numpy as np


D_MODEL = 1024
BATCH = 4
SEQ = 4096
DEPTH = 2

SSD_HEADS = 16
SSD_HEAD_DIM = 64
D_SSD = SSD_HEADS * SSD_HEAD_DIM
SSD_GROUPS = 2
SSD_STATE = 128
SSD_CONV = 4
SSD_CHUNK = 256
CONV_DIM = D_SSD + 2 * SSD_GROUPS * SSD_STATE
ATT_HEADS = 8
ATT_HEAD_DIM = 128
D_ATT = ATT_HEADS * ATT_HEAD_DIM
IDX_HEADS = 8
IDX_HEAD_DIM = 64
TOPK_MAX = 256
Q_BLOCK = 128
ROPE_THETA = 500000.0
ATT_ROPE_DIM = ATT_HEAD_DIM // 4
IDX_ROPE_DIM = IDX_HEAD_DIM // 4
D_MIX = D_SSD + D_ATT
D_FF = 2816
EPS = 1e-6
MIX_SPLITS = (D_SSD, CONV_DIM, SSD_HEADS, D_ATT, D_ATT, D_ATT,
              IDX_HEADS * IDX_HEAD_DIM, IDX_HEAD_DIM, IDX_HEADS)
SPLIT_POINTS = tuple(int(p) for p in np.cumsum(MIX_SPLITS)[:-1])
D_IN_PROJ = sum(MIX_SPLITS)

kernel_name = 'hybrid_ssd_dsa_macaron'


def rmsnorm(x, g):
    xf = x.astype(jnp.float32)
    y = xf * lax.rsqrt(jnp.mean(xf * xf, axis=-1, keepdims=True) + EPS)
    return (y * g.astype(jnp.float32)).astype(x.dtype)


def swiglu_ffn(x, w_in, w_out):
    gate, up = jnp.split(x @ w_in, 2, axis=-1)
    return (jax.nn.silu(gate) * up) @ w_out


def partial_rope(x, positions, rot_dim):
    inv_freq = ROPE_THETA ** (-jnp.arange(0, rot_dim, 2, dtype=jnp.float32) / rot_dim)
    ang = positions.astype(jnp.float32)[..., None] * inv_freq
    cos = jnp.cos(ang)[:, :, None, :]
    sin = jnp.sin(ang)[:, :, None, :]
    xr = x[..., :rot_dim].astype(jnp.float32)
    x1, x2 = jnp.split(xr, 2, axis=-1)
    rot = jnp.concatenate([x1 * cos - x2 * sin, x2 * cos + x1 * sin], axis=-1)
    return jnp.concatenate([rot.astype(x.dtype), x[..., rot_dim:]], axis=-1)


def causal_dwconv(x, w, b):
    k = w.shape[0]
    y = lax.conv_general_dilated(x, w[:, None, :].astype(x.dtype), window_strides=(1,),
                                 padding=[(k - 1, 0)],
                                 dimension_numbers=('NWC', 'WIO', 'NWC'),
                                 feature_group_count=x.shape[-1])
    return y + b.astype(x.dtype)


def segsum_exp(a):
    l = a.shape[-1]
    cs = jnp.cumsum(a, axis=-1)
    seg = cs[..., :, None] - cs[..., None, :]
    mask = jnp.tril(jnp.ones((l, l), dtype=bool))
    return jnp.exp(jnp.where(mask, seg, -jnp.inf))


def ssd_chunked(xh, dt, a, bmat, cmat, chunk):
    bsz, L, H, P = xh.shape
    G, N = bmat.shape[-2:]
    E = H // G
    nc = L // chunk
    x = (xh.astype(jnp.float32) * dt[..., None]).reshape(bsz, nc, chunk, G, E, P)
    adt = jnp.moveaxis((dt * a).reshape(bsz, nc, chunk, G, E), 2, -1)
    a_cs = jnp.cumsum(adt, axis=-1)
    bc = bmat.astype(jnp.float32).reshape(bsz, nc, chunk, G, N)
    cc = cmat.astype(jnp.float32).reshape(bsz, nc, chunk, G, N)
    decay = segsum_exp(adt)
    cb = jnp.einsum('bclgn,bcsgn->bcgls', cc, bc)
    y_diag = jnp.einsum('bcgls,bcgels,bcsgep->bclgep', cb, decay, x)
    decay_states = jnp.exp(a_cs[..., -1:] - a_cs)
    states = jnp.einsum('bclgn,bcgel,bclgep->bcgepn', bc, decay_states, x)
    chunk_decay = jnp.exp(a_cs[..., -1])

    def step(h, inp):
        st, dec = inp
        return h * dec[..., None, None] + st, h

    h0 = jnp.zeros((bsz, G, E, P, N), jnp.float32)
    _, h_in = lax.scan(step, h0, (jnp.moveaxis(states, 1, 0), jnp.moveaxis(chunk_decay, 1, 0)))
    h_in = jnp.moveaxis(h_in, 0, 1)
    y_off = jnp.einsum('bclgn,bcgepn,bcgel->bclgep', cc, h_in, jnp.exp(a_cs))
    return (y_diag + y_off).reshape(bsz, L, H, P)


def ssd_mixer(z, xbc, dt_raw, conv_w, conv_b, dt_bias, a_log, d_skip, norm_g):
    bsz, L, _ = z.shape
    xbc = jax.nn.silu(causal_dwconv(xbc, conv_w, conv_b))
    xs, bm, cm = jnp.split(xbc, [D_SSD, D_SSD + SSD_GROUPS * SSD_STATE], axis=-1)
    xh = xs.reshape(bsz, L, SSD_HEADS, SSD_HEAD_DIM)
    bm = bm.reshape(bsz, L, SSD_GROUPS, SSD_STATE)
    cm = cm.reshape(bsz, L, SSD_GROUPS, SSD_STATE)
    dt = jax.nn.softplus(dt_raw.astype(jnp.float32) + dt_bias.astype(jnp.float32))
    a = -jnp.exp(a_log.astype(jnp.float32))
    chunk = math.gcd(SSD_CHUNK, L)
    y = ssd_chunked(xh, dt, a, bm, cm, chunk)
    y = y + xh.astype(jnp.float32) * d_skip.astype(jnp.float32)[:, None]
    y = y.reshape(bsz, L, D_SSD) * jax.nn.silu(z.astype(jnp.float32))
    yg = y.reshape(bsz, L, SSD_GROUPS, D_SSD // SSD_GROUPS)
    yg = yg * lax.rsqrt(jnp.mean(yg * yg, axis=-1, keepdims=True) + EPS)
    return (yg.reshape(bsz, L, D_SSD) * norm_g.astype(jnp.float32)).astype(z.dtype)


def dsa_mixer(q, k, v, q_idx, k_idx, w_idx, positions):
    bsz, L, _ = q.shape
    q = partial_rope(q.reshape(bsz, L, ATT_HEADS, ATT_HEAD_DIM), positions, ATT_ROPE_DIM)
    k = partial_rope(k.reshape(bsz, L, ATT_HEADS, ATT_HEAD_DIM), positions, ATT_ROPE_DIM)
    v = v.reshape(bsz, L, ATT_HEADS, ATT_HEAD_DIM)
    qi = partial_rope(q_idx.reshape(bsz, L, IDX_HEADS, IDX_HEAD_DIM), positions, IDX_ROPE_DIM)
    ki = partial_rope(k_idx[:, :, None, :], positions, IDX_ROPE_DIM)[:, :, 0].astype(jnp.float32)
    wi = w_idx.astype(jnp.float32) * IDX_HEADS ** -0.5
    topk = min(TOPK_MAX, L // 4)
    n_blocks = L // Q_BLOCK
    key_pos = jnp.arange(L)
    att_scale = ATT_HEAD_DIM ** -0.5
    idx_scale = IDX_HEAD_DIM ** -0.5

    def block(i):
        start = i * Q_BLOCK
        qb = lax.dynamic_slice_in_dim(q, start, Q_BLOCK, axis=1)
        qib = lax.dynamic_slice_in_dim(qi, start, Q_BLOCK, axis=1)
        wb = lax.dynamic_slice_in_dim(wi, start, Q_BLOCK, axis=1)
        t = start + jnp.arange(Q_BLOCK)
        causal = key_pos[None, :] <= t[:, None]
        logit_idx = jnp.einsum('bthd,bsd->bths', qib.astype(jnp.float32), ki) * idx_scale
        score = jnp.einsum('bth,bths->bts', wb, jax.nn.relu(logit_idx))
        score = jnp.where(causal[None], score, -jnp.inf)
        _, sel = lax.top_k(score, topk)
        k_sel = jax.vmap(lambda kb, ib: kb[ib])(k, sel)
        v_sel = jax.vmap(lambda vb, ib: vb[ib])(v, sel)
        valid = sel <= t[None, :, None]
        s = jnp.einsum('bthd,btkhd->bhtk', qb.astype(jnp.float32),
                       k_sel.astype(jnp.float32)) * att_scale
        s = jnp.where(valid[:, None], s, -jnp.inf)
        p = jax.nn.softmax(s, axis=-1)
        o = jnp.einsum('bhtk,btkhd->bthd', p, v_sel.astype(jnp.float32))
        return o.astype(q.dtype)

    out = lax.map(block, jnp.arange(n_blocks))
    return jnp.moveaxis(out, 0, 1).reshape(bsz, L, D_ATT)


def setup_inputs(seed: int = 0) -> dict:
    key = jax.random.key(seed)
    ks = jax.random.split(key, 20)
    f32 = jnp.float32

    def dense(k, shape, fan_in):
        return jax.random.normal(k, shape, f32) * fan_in ** -0.5

    def gain(k, shape):
        return 1.0 + 0.02 * jax.random.normal(k, shape, f32)

    x = jax.random.normal(ks[0], (BATCH, SEQ, D_MODEL), f32)
    offset = jax.random.randint(ks[1], (BATCH, 1), 0, 1024, dtype=jnp.int32)
    positions = (offset + jnp.arange(SEQ, dtype=jnp.int32)[None, :]).astype(jnp.int32)
    dt0 = jnp.exp(jax.random.uniform(ks[10], (DEPTH, SSD_HEADS), f32,
                                     minval=math.log(1e-3), maxval=math.log(1e-1)))
    dt_bias = dt0 + jnp.log(-jnp.expm1(-dt0))
    a_log = jnp.log(jax.random.uniform(ks[11], (DEPTH, SSD_HEADS), f32, minval=1.0, maxval=16.0))
    return {
        'x': x,
        'positions': positions,
        'norm_ffn1': gain(ks[2], (DEPTH, D_MODEL)),
        'w_ffn1_in': dense(ks[3], (DEPTH, D_MODEL, 2 * D_FF), D_MODEL),
        'w_ffn1_out': dense(ks[4], (DEPTH, D_FF, D_MODEL), D_FF),
        'norm_mix': gain(ks[5], (DEPTH, D_MODEL)),
        'w_mix_in': dense(ks[6], (DEPTH, D_MODEL, D_IN_PROJ), D_MODEL),
        'conv_w': dense(ks[7], (DEPTH, SSD_CONV, CONV_DIM), SSD_CONV),
        'conv_b': 0.02 * jax.random.normal(ks[8], (DEPTH, CONV_DIM), f32),
        'dt_bias': dt_bias,
        'a_log': a_log,
        'd_skip': 1.0 + 0.1 * jax.random.normal(ks[9], (DEPTH, SSD_HEADS), f32),
        'ssd_norm': gain(ks[12], (DEPTH, D_SSD)),
        'w_mix_out': dense(ks[13], (DEPTH, D_MIX, D_MODEL), D_MIX),
        'norm_ffn2': gain(ks[14], (DEPTH, D_MODEL)),
        'w_ffn2_in': dense(ks[15], (DEPTH, D_MODEL, 2 * D_FF), D_MODEL),
        'w_ffn2_out': dense(ks[16], (DEPTH, D_FF, D_MODEL), D_FF),
        'final_norm': gain(ks[17], (D_MODEL,)),
    }


def reference(x, positions, norm_ffn1, w_ffn1_in, w_ffn1_out, norm_mix, w_mix_in,
              conv_w, conv_b, dt_bias, a_log, d_skip, ssd_norm, w_mix_out,
              norm_ffn2, w_ffn2_in, w_ffn2_out, final_norm):
    h = x
    for i in range(DEPTH):
        h = h + 0.5 * swiglu_ffn(rmsnorm(h, norm_ffn1[i]), w_ffn1_in[i], w_ffn1_out[i])
        u = rmsnorm(h, norm_mix[i]) @ w_mix_in[i]
        z, xbc, dt_raw, q, k, v, q_idx, k_idx, w_idx = jnp.split(u, SPLIT_POINTS, axis=-1)
        y_ssd = ssd_mixer(z, xbc, dt_raw, conv_w[i], conv_b[i], dt_bias[i], a_log[i],
                          d_skip[i], ssd_norm[i])
        y_att = dsa_mixer(q, k, v, q_idx, k_idx, w_idx, positions)
        h = h + jnp.concatenate([y_ssd, y_att], axis=-1) @ w_mix_out[i]
        h = h + 0.5 * swiglu_ffn(rmsnorm(h, norm_ffn2[i]), w_ffn2_in[i], w_ffn2_out[i])
    return rmsnorm(h, final_norm)
```

```cpp
#include <hip/hip_runtime.h>
#include <cstdio>
#include <cstdint>
#include <cmath>

#define DI __device__ __forceinline__
#define LAS __attribute__((address_space(3)))
typedef unsigned short bf16_t;
typedef short bf16x8 __attribute__((ext_vector_type(8)));
typedef short s16x4 __attribute__((ext_vector_type(4)));
typedef float f32x2 __attribute__((ext_vector_type(2)));
typedef float f32x4 __attribute__((ext_vector_type(4)));
typedef float f32x16 __attribute__((ext_vector_type(16)));
typedef unsigned u32x2 __attribute__((ext_vector_type(2)));
typedef unsigned u32x4 __attribute__((ext_vector_type(4)));
typedef __bf16 bf2_t __attribute__((ext_vector_type(2)));

DI unsigned pk2(float a, float b) { bf2_t v = __builtin_convertvector((f32x2){a, b}, bf2_t); return __builtin_bit_cast(unsigned, v); }
DI bf16_t f2bf(float a) { return (bf16_t)(pk2(a, 0.f) & 0xffffu); }
DI float bf2f(bf16_t v) { return __uint_as_float(((unsigned)v) << 16); }
DI float bflo(unsigned w) { return __uint_as_float(w << 16); }
DI float bfhi(unsigned w) { return __uint_as_float(w & 0xffff0000u); }
DI bf16x8 pack8(f32x4 a, f32x4 b) { u32x4 w = {pk2(a[0], a[1]), pk2(a[2], a[3]), pk2(b[0], b[1]), pk2(b[2], b[3])}; return __builtin_bit_cast(bf16x8, w); }
DI float silu_f(float x) { return x * __builtin_amdgcn_rcpf(1.0f + __builtin_amdgcn_exp2f(-1.4426950408889634f * x)); }
DI int crow(int r, int hi) { return (r & 3) + 8 * (r >> 2) + 4 * hi; }
#define MFMA32(a, b, c) __builtin_amdgcn_mfma_f32_32x32x16_bf16((a), (b), (c), 0, 0, 0)

constexpr int NB = 4, SEQ = 4096, MTOK = NB * SEQ, DM = 1024, DFF = 2816, NFFIN = 2 * DFF;
constexpr int NMIXB = 3840, NMIXA = 2560, DINPROJ = 6232, XBCW = 1536;
constexpr int NTHR = 512;
constexpr float EPS = 1e-6f;
constexpr int LDS_BYTES = 147456;
constexpr int LDS_BAR_OFF = LDS_BYTES - 16;

constexpr size_t KiB = 1024, MiB = 1024 * 1024;
constexpr size_t WS_CTL = 0;
constexpr size_t WS_SSP = 64 * KiB;
constexpr size_t WS_ROPEA = WS_SSP + 1 * MiB;
constexpr size_t WS_ROPEI = WS_ROPEA + 2 * MiB;
constexpr size_t WS_SSQ = WS_ROPEI + 1 * MiB;
constexpr size_t WS_CDEC = WS_SSQ + 1 * MiB;
constexpr size_t WS_WB = WS_CDEC + 64 * KiB;
constexpr size_t WS_HB = WS_WB + 50 * MiB;
constexpr size_t WS_YMIX = WS_HB + 32 * MiB;
constexpr size_t WS_MISC = WS_YMIX + 64 * MiB;
constexpr size_t WS_R = WS_MISC + 8 * MiB;
constexpr size_t WS_END = WS_R + 90 * MiB;
constexpr size_t R_K = 0, R_V = 32 * MiB, R_QI = 64 * MiB, R_KI = 80 * MiB, R_MASK = 82 * MiB;
constexpr size_t R_XBC = 0, R_STATES = 48 * MiB;
constexpr size_t R_ACT = 0;
constexpr size_t WB_1IN = 0, WB_1OUT = WB_1IN + (size_t)NFFIN * DM, WB_MIXB = WB_1OUT + (size_t)DM * DFF, WB_MIXA = WB_MIXB + (size_t)NMIXB * DM,
                 WB_MO = WB_MIXA + (size_t)NMIXA * DM, WB_2IN = WB_MO + (size_t)DM * 2048, WB_2OUT = WB_2IN + (size_t)NFFIN * DM, WB_END = WB_2OUT + (size_t)DM * DFF;
static_assert(WB_END * 2 <= 50 * MiB, "weights");

struct Args { const float* in[18]; float* out; unsigned char* ws; float invf[24]; int ph_lo, ph_hi; };

typedef const __attribute__((address_space(4))) unsigned char* kargp_t;
DI kargp_t karg_base() { kargp_t ka = (kargp_t)__builtin_amdgcn_kernarg_segment_ptr(); asm volatile("" : "+s"(ka)); return ka; }
DI const float* argp(int i) { return *(const float* const __attribute__((address_space(4)))*)(karg_base() + 8 * i); }
struct Ctx {
    LAS unsigned char* lds; int tid, lane, wid; unsigned char* ws;
    DI const float* x() const { return argp(0); }
    DI const int* pos() const { return (const int*)argp(1); }
    DI float* h() const { return (float*)argp(18); }
    DI float* ssp() const { return (float*)(ws + WS_SSP); }
    DI f32x2* ropeA() const { return (f32x2*)(ws + WS_ROPEA); }
    DI f32x2* ropeI() const { return (f32x2*)(ws + WS_ROPEI); }
    DI float* ssq() const { return (float*)(ws + WS_SSQ); }
    DI float* cdec() const { return (float*)(ws + WS_CDEC); }
    DI bf16_t* wb() const { return (bf16_t*)(ws + WS_WB); }
    DI bf16_t* hb() const { return (bf16_t*)(ws + WS_HB); }
    DI bf16_t* ymix() const { return (bf16_t*)(ws + WS_YMIX); }
    DI float* misc() const { return (float*)(ws + WS_MISC); }
    DI bf16_t* kbuf() const { return (bf16_t*)(ws + WS_R + R_K); }
    DI bf16_t* vbuf() const { return (bf16_t*)(ws + WS_R + R_V); }
    DI bf16_t* qi() const { return (bf16_t*)(ws + WS_R + R_QI); }
    DI bf16_t* ki() const { return (bf16_t*)(ws + WS_R + R_KI); }
    DI unsigned* mask() const { return (unsigned*)(ws + WS_R + R_MASK); }
    DI bf16_t* xbc() const { return (bf16_t*)(ws + WS_R + R_XBC); }
    DI float* states() const { return (float*)(ws + WS_R + R_STATES); }
    DI bf16_t* act() const { return (bf16_t*)(ws + WS_R + R_ACT); }
};

DI float row_rstd(const float* ssp, int row) {
    const f32x4* p = (const f32x4*)(ssp + (size_t)row * 16);
    const f32x4 a = p[0], b = p[1], c = p[2], d = p[3];
    const float s = ((a[0] + a[1]) + (a[2] + a[3])) + ((b[0] + b[1]) + (b[2] + b[3])) + ((c[0] + c[1]) + (c[2] + c[3])) + ((d[0] + d[1]) + (d[2] + d[3]));
    return rsqrtf(s * (1.0f / 1024.0f) + EPS);
}
namespace pg8 {
#define PG8_LAS __attribute__((address_space(3)))
typedef unsigned short bf16_t;
typedef short bf16x8 __attribute__((ext_vector_type(8)));
typedef float f32x4 __attribute__((ext_vector_type(4)));
typedef unsigned u32x4 __attribute__((ext_vector_type(4)));
constexpr int BM = 256, BK = 64, HALF = 128, HTB = HALF * BK * 2  , STAGE_BYTES = 8 * HTB, NXCD = 8, WGM = 8;

__host__ __device__ __forceinline__ int lds_byte(int r, int c) { const int st = (r >> 4) * 2 + (c >> 5), rr = r & 15, cc = c & 31, ob = rr * 64 + cc * 2; return st * 1024 + (ob ^ (((ob >> 9) & 1) << 5)); }
__host__ __device__ __forceinline__ void stage_rc(int b, int& R, int& C) { const int st = b / 1024, sb = b % 1024, swz = sb ^ (((sb >> 9) & 1) << 5); R = (st >> 1) * 16 + swz / 64; C = (st & 1) * 32 + (swz % 64) / 2; }
__host__ __device__ __forceinline__ int perm32(int rho) { const int n = rho >> 4, i = rho & 15; return 8 * (i >> 2) + 4 * n + (i & 3); }

struct Unit { int pm, pn; };
struct Gemm { const bf16_t* A; const bf16_t* Bt; int M, N, K; };

struct StaticOrder {
    int nM, nN, nwg, G, c;
    __host__ __device__ void init(int M, int N, int G_, int c_) { nM = M / BM; nN = N / BM; nwg = nM * nN; G = G_; c = c_; }
    __host__ __device__ bool next(int i, Unit& u) const {
        const long L = (long)i * G + c; if (L >= nwg) return false;
        int wgid = (int)L; { const int q = nwg / NXCD, r = nwg % NXCD, xcd = wgid % NXCD, off = wgid / NXCD; wgid = (xcd < r ? xcd * (q + 1) : r * (q + 1) + (xcd - r) * q) + off; }
        const int nig = WGM * nN, gid = wgid / nig, fm = gid * WGM, gsz = (nM - fm) < WGM ? (nM - fm) : WGM;
        u.pm = fm + ((wgid % nig) % gsz); u.pn = (wgid % nig) / gsz; return true;
    }
    __device__ __forceinline__ void a_ready(const Unit&) const {}
    __device__ __forceinline__ void done(const Unit&) const {}
};
template <class Epi, class Sched, bool STAMP = false>
__device__ __forceinline__ void gemm_phase(PG8_LAS unsigned char* lds, const Gemm g, const Sched& S, const Epi& E, unsigned long long* stamps) {
    int tid_ = threadIdx.x; asm volatile("" : "+v"(tid_));
    const int tid = tid_, wid = __builtin_amdgcn_readfirstlane(tid >> 6), lane = tid & 63, wr = wid >> 2, wc = wid & 3, fr = lane & 15, fq = lane >> 4;
    const int K = g.K, nt = K / BK;
    int ts_lo = 0, ts_hi = 0, nts = 0; const unsigned long long rt_entry = STAMP ? (unsigned long long)wall_clock64() : 0ull;
#define PG8_STAMP() do { if (STAMP && wid == 0 && nts < 64) { const unsigned long long _c = (unsigned long long)clock64(); \
        ts_lo = (lane == nts) ? (int)(unsigned)_c : ts_lo; ts_hi = (lane == nts) ? (int)(unsigned)(_c >> 32) : ts_hi; ++nts; } } while (0)
    PG8_STAMP();
    unsigned voffA[2], voffB[2];
#pragma unroll
    for (int i = 0; i < 2; ++i) { int R, C; stage_rc(tid * 16 + i * 8192, R, C); const int Rb = Epi::PERM ? ((R & ~31) + perm32(R & 31)) : R;
        voffA[i] = (unsigned)(R * K + C) * 2u; voffB[i] = (unsigned)(Rb * K + C) * 2u; }
    const size_t kstep = (size_t)(BK * 2);
    const size_t hstep = (size_t)HALF * K * 2;
    const size_t tstep = 2 * hstep;
    const unsigned ldsw = (unsigned)wid * 1024u;
    const int aoff = lds_byte(wr * 64 + fr, fq * 8), boff = lds_byte(wc * 32 + fr, fq * 8);
#define PG8_SA(b, h) (((b) * 2 + (h)) * HTB)
#define PG8_SB(b, h) ((4 + (b) * 2 + (h)) * HTB)
#define PG8_STAGE(bufoff, gbase, voff) do { _Pragma("unroll") for (int _i = 0; _i < 2; ++_i) \
        __builtin_amdgcn_global_load_lds((const unsigned*)((const char*)(gbase) + (voff)[_i]), (PG8_LAS unsigned*)(lds + (bufoff) + ldsw + _i * 8192), 16, 0, 0); } while (0)
#define PG8_LDA(dst, b, h) do { _Pragma("unroll") for (int m = 0; m < 4; ++m) _Pragma("unroll") for (int k = 0; k < 2; ++k) dst[m][k] = *(const PG8_LAS bf16x8*)(lds + PG8_SA(b, h) + aoff + m * 2048 + k * 1024); } while (0)
#define PG8_LDB(dst, b, h) do { _Pragma("unroll") for (int n = 0; n < 2; ++n) _Pragma("unroll") for (int k = 0; k < 2; ++k) dst[n][k] = *(const PG8_LAS bf16x8*)(lds + PG8_SB(b, h) + boff + n * 2048 + k * 1024); } while (0)
#define PG8_MMA(ai, bj, At, Bt) do { __builtin_amdgcn_s_setprio(1); _Pragma("unroll") for (int m = 0; m < 4; ++m) _Pragma("unroll") for (int n = 0; n < 2; ++n) _Pragma("unroll") for (int k = 0; k < 2; ++k) \
        acc[ai][bj][m][n] = __builtin_amdgcn_mfma_f32_16x16x32_bf16(Bt[n][k], At[m][k], acc[ai][bj][m][n], 0, 0, 0); __builtin_amdgcn_s_setprio(0); } while (0)
#define PG8_WAIT_V(n) asm volatile("s_waitcnt vmcnt(" #n ")" ::: "memory")
#define PG8_WAIT_L(n) asm volatile("s_waitcnt lgkmcnt(" #n ")" ::: "memory")
#define PG8_BAR __builtin_amdgcn_s_barrier()
#define PG8_SCHED __builtin_amdgcn_sched_barrier(0)
    Unit cur, nxt; int ui = 0;
    if (!S.next(0, cur)) return;
    f32x4 acc[2][2][4][2];
#pragma unroll
    for (int a = 0; a < 2; ++a)
#pragma unroll
        for (int b = 0; b < 2; ++b)
#pragma unroll
            for (int m = 0; m < 4; ++m)
#pragma unroll
                for (int n = 0; n < 2; ++n) acc[a][b][m][n] = (f32x4){0.f, 0.f, 0.f, 0.f};
    bf16x8 At[4][2], B0[2][2], B1[2][2];
    const char* cA = (const char*)g.A + (size_t)cur.pm * tstep; const char* cB = (const char*)g.Bt + (size_t)cur.pn * tstep;
    S.a_ready(cur);
    if constexpr (Epi::PREP) E.prep(cur, 0, tid);
    PG8_STAGE(PG8_SB(0, 0), cB, voffB); PG8_STAGE(PG8_SA(0, 0), cA, voffA); PG8_STAGE(PG8_SB(0, 1), cB + hstep, voffB); PG8_STAGE(PG8_SA(0, 1), cA + hstep, voffA);
    if (wr == 1) PG8_BAR;
    PG8_WAIT_V(4); PG8_BAR;
    PG8_STAGE(PG8_SB(1, 0), cB + kstep, voffB); PG8_STAGE(PG8_SA(1, 0), cA + kstep, voffA); PG8_STAGE(PG8_SB(1, 1), cB + hstep + kstep, voffB);
    PG8_WAIT_V(6); PG8_BAR;
    PG8_STAMP();
    for (;;) {
        const bool has_next = S.next(ui + 1, nxt);
        const char* nA = has_next ? (const char*)g.A + (size_t)nxt.pm * tstep : cA; const char* nB = has_next ? (const char*)g.Bt + (size_t)nxt.pn * tstep : cB;
        for (int t = 0; t < nt; t += 2) {
            if constexpr (Epi::KSCALE) { if (t == 8 || t == 16) E.kscale(acc, cur, t, wr, fr); }
            const bool last = (t == nt - 2);
            const char* a1 = cA + (size_t)(t + 1) * kstep;
            const char* a2 = last ? nA : cA + (size_t)(t + 2) * kstep; const char* b2 = last ? nB : cB + (size_t)(t + 2) * kstep;
            const char* a3 = a2 + kstep; const char* b3 = b2 + kstep;
            if (last && has_next) { S.a_ready(nxt); if constexpr (Epi::PREP) E.prep(nxt, (ui + 1) & 1, tid); }
            PG8_LDB(B0, 0, 0); PG8_SCHED; PG8_LDA(At, 0, 0); PG8_STAGE(PG8_SA(1, 1), a1 + hstep, voffA);
            PG8_WAIT_L(8); PG8_BAR; PG8_WAIT_L(0); PG8_MMA(0, 0, At, B0); PG8_BAR; PG8_SCHED;
            PG8_LDB(B1, 0, 1); PG8_STAGE(PG8_SB(0, 0), b2, voffB);
            PG8_BAR; PG8_WAIT_L(0); PG8_MMA(0, 1, At, B1); PG8_BAR;
            PG8_LDA(At, 0, 1); PG8_STAGE(PG8_SA(0, 0), a2, voffA);
            PG8_BAR; PG8_WAIT_L(0); PG8_MMA(1, 0, At, B0); PG8_BAR; PG8_SCHED;
            PG8_STAGE(PG8_SB(0, 1), b2 + hstep, voffB);
            PG8_WAIT_V(6); PG8_BAR; PG8_MMA(1, 1, At, B1); PG8_BAR;
            PG8_LDB(B0, 1, 0); PG8_SCHED; PG8_LDA(At, 1, 0); PG8_STAGE(PG8_SA(0, 1), a2 + hstep, voffA);
            PG8_WAIT_L(8); PG8_BAR; PG8_WAIT_L(0); PG8_MMA(0, 0, At, B0); PG8_BAR; PG8_SCHED;
            PG8_LDB(B1, 1, 1); PG8_STAGE(PG8_SB(1, 0), b3, voffB);
            PG8_BAR; PG8_WAIT_L(0); PG8_MMA(0, 1, At, B1); PG8_BAR;
            PG8_LDA(At, 1, 1); PG8_STAGE(PG8_SA(1, 0), a3, voffA);
            PG8_BAR; PG8_WAIT_L(0); PG8_MMA(1, 0, At, B0); PG8_BAR; PG8_SCHED;
            PG8_STAGE(PG8_SB(1, 1), b3 + hstep, voffB);
            PG8_WAIT_V(6); PG8_BAR; PG8_MMA(1, 1, At, B1); PG8_BAR;
        }
        PG8_STAMP();
        if constexpr (!Epi::AFTER_DRAIN) { if constexpr (Epi::PREP) E(acc, cur, wr, wc, fr, fq, ui & 1); else E(acc, cur, wr, wc, fr, fq); S.done(cur); }
        PG8_STAMP();
        if (!has_next) break;
#pragma unroll
        for (int a = 0; a < 2; ++a)
#pragma unroll
            for (int b = 0; b < 2; ++b)
#pragma unroll
                for (int m = 0; m < 4; ++m)
#pragma unroll
                    for (int n = 0; n < 2; ++n) acc[a][b][m][n] = (f32x4){0.f, 0.f, 0.f, 0.f};
        cur = nxt; cA = nA; cB = nB; ++ui;
    }
    PG8_WAIT_V(0);
    if (wr == 0) PG8_BAR;
    PG8_BAR;
    if constexpr (Epi::AFTER_DRAIN) { E.fused(acc, cur, wr, wc, fr, fq, lds, wid, lane); S.done(cur); }
    PG8_STAMP();
    if (STAMP && wid == 0) { stamps[lane] = lane < nts ? (((unsigned long long)(unsigned)ts_hi << 32) | (unsigned)ts_lo) : 0ull;
        if (lane == 62) stamps[62] = rt_entry; if (lane == 63) stamps[63] = (unsigned long long)wall_clock64(); }
#undef PG8_STAMP
#undef PG8_SA
#undef PG8_SB
#undef PG8_STAGE
#undef PG8_LDA
#undef PG8_LDB
#undef PG8_MMA
#undef PG8_WAIT_V
#undef PG8_WAIT_L
#undef PG8_BAR
#undef PG8_SCHED
}
}
#define XB_TMO      128
#define XB_XCNT(j)  (256  + 64 * (j))
#define XB_XSUB(j)  (1280 + 64 * (j))
#define XB_XGEN(j)  (2304 + 64 * (j))
#define XB_TOP      3328
#define XB_TOPGEN   3392
#define XCD_BAR_WORDS 3456
#define XB_SPIN_CAP (1u << 18)
#define LAS __attribute__((address_space(3)))

__device__ __forceinline__ unsigned xb_ld(unsigned* p)              { return __hip_atomic_load(p, __ATOMIC_RELAXED, __HIP_MEMORY_SCOPE_AGENT); }
__device__ __forceinline__ unsigned xb_add(unsigned* p, unsigned v) { return __hip_atomic_fetch_add(p, v, __ATOMIC_RELAXED, __HIP_MEMORY_SCOPE_AGENT); }
__device__ __forceinline__ unsigned xb_xcc_id() { return (unsigned)__builtin_amdgcn_s_getreg((3 << 11) | 20) & 0xFu; }
#define XB_SPIN(cond, bar) do { unsigned _sp = 0; while (cond) { __builtin_amdgcn_s_sleep(1); \
    if ((++_sp & 255u) == 0u) { if (xb_ld(&(bar)[XB_TMO])) break; if (_sp > XB_SPIN_CAP) { atomicAdd(&(bar)[XB_TMO], 1u); break; } } } } while (0)

struct XcdBarrier {
    unsigned* bar; unsigned x;
    volatile LAS unsigned* st;
};

__device__ __forceinline__ XcdBarrier xcd_barrier_post(unsigned* bar, volatile LAS unsigned* st) {
    XcdBarrier b; b.bar = bar; b.x = xb_xcc_id(); b.st = st;
    if (threadIdx.x == 0) (void)xb_add(&bar[XB_XCNT(b.x)], 1u);
    return b;
}
__device__ __forceinline__ void xcd_barrier_complete(unsigned* bar, unsigned x, unsigned& nloc, unsigned& nx) {
    const unsigned G = gridDim.x * gridDim.y * gridDim.z;
    unsigned sum, cnt, mine, sp = 0u;
    for (;;) {
        sum = 0u; cnt = 0u; mine = 0u;
#pragma unroll
        for (unsigned j = 0; j < 16; ++j) { const unsigned c = xb_ld(&bar[XB_XCNT(j)]); sum += c; cnt += (c > 0u) ? 1u : 0u; mine = (j == x) ? c : mine; }
        if (sum == G) break;
        __builtin_amdgcn_s_sleep(1);
        if ((++sp & 255u) == 0u) { if (xb_ld(&bar[XB_TMO])) break; if (sp > XB_SPIN_CAP) { atomicAdd(&bar[XB_TMO], 1u); break; } }
    }
    nloc = mine > 0u ? mine : 1u; nx = cnt > 0u ? cnt : 1u;
}

__device__ __forceinline__ void xcd_barrier(const XcdBarrier& b) {
    asm volatile("s_waitcnt vmcnt(0)" ::: "memory");
    __syncthreads();
    if (threadIdx.x == 0) {
        unsigned* bar = b.bar;
        __builtin_amdgcn_s_waitcnt(0);
        unsigned nloc = b.st[0], nx = b.st[1];
        if (nloc == 0u) { xcd_barrier_complete(bar, b.x, nloc, nx); b.st[0] = nloc; b.st[1] = nx; }
        const unsigned old = xb_add(&bar[XB_XSUB(b.x)], 1u);
        const unsigned gen = old / nloc;
        if (old + 1u == (gen + 1u) * nloc) {
            __builtin_amdgcn_fence(__ATOMIC_RELEASE, "agent");
            asm volatile("s_waitcnt vmcnt(0)" ::: "memory");
            const unsigned og = xb_add(&bar[XB_TOP], 1u);
            const unsigned tg = og / nx;
            if (og + 1u == (tg + 1u) * nx) xb_add(&bar[XB_TOPGEN], 1u);
            else XB_SPIN(xb_ld(&bar[XB_TOPGEN]) == tg, bar);
            __builtin_amdgcn_fence(__ATOMIC_ACQUIRE, "agent");
            xb_add(&bar[XB_XGEN(b.x)], 1u);
            asm volatile("s_waitcnt vmcnt(0)" ::: "memory");
        } else {
            XB_SPIN(xb_ld(&bar[XB_XGEN(b.x)]) == gen, bar);
            __builtin_amdgcn_fence(__ATOMIC_ACQUIRE, "agent");
            asm volatile("s_waitcnt vmcnt(0)" ::: "memory");
        }
    }
    __syncthreads();
}

constexpr int RS_LDS_OFF = 131072;
DI void prep_rstd(const float* ssp, LAS float* tab, int pm, int par, int tid) {
    const int row = tid >> 1, hf = tid & 1;
    const f32x4* p = (const f32x4*)(ssp + (size_t)(pm * 256 + row) * 16 + hf * 8);
    const f32x4 a = p[0], b = p[1];
    float s = ((a[0] + a[1]) + (a[2] + a[3])) + ((b[0] + b[1]) + (b[2] + b[3]));
    s += __shfl_xor(s, 1);
    if (hf == 0) tab[par * 256 + row] = rsqrtf(s * (1.0f / 1024.0f) + EPS);
}
struct EpiSwiGLU {
    static constexpr bool PERM = true, AFTER_DRAIN = false, KSCALE = false, PREP = true;
    bf16_t* act; const float* ssp; LAS float* tab;
    DI void prep(const pg8::Unit& u, int par, int tid) const { prep_rstd(ssp, tab, u.pm, par, tid); }
    DI void operator()(const f32x4 (&acc)[2][2][4][2], const pg8::Unit& u, int wr, int wc, int fr, int fq, int par) const {
        const int row0 = u.pm * 256 + wr * 64 + fr, col = u.pn * 128 + wc * 32 + 8 * fq;
#pragma unroll
        for (int ai = 0; ai < 2; ++ai)
#pragma unroll
            for (int m = 0; m < 4; ++m) {
                const int row = row0 + ai * 128 + m * 16; const float rs = tab[par * 256 + ai * 128 + wr * 64 + m * 16 + fr];
                float o[8];
#pragma unroll
                for (int n = 0; n < 2; ++n)
#pragma unroll
                    for (int e = 0; e < 4; ++e) o[n * 4 + e] = silu_f(acc[ai][0][m][n][e] * rs) * (acc[ai][1][m][n][e] * rs);
                u32x4 w = {pk2(o[0], o[1]), pk2(o[2], o[3]), pk2(o[4], o[5]), pk2(o[6], o[7])};
                *(u32x4*)(act + (size_t)row * DFF + col) = w;
                asm volatile("" ::: "memory");
            }
    }
};
template <bool KS> struct EpiResidT {
    static constexpr bool PERM = false, AFTER_DRAIN = false, KSCALE = KS, PREP = false;
    const float* hin; float* hout; bf16_t* hb; float* ssp; const float* ssq; int dummy;
    DI void kscale(f32x4 (&acc)[2][2][4][2], const pg8::Unit& u, int t, int wr, int fr) const {
        int fr_ = fr; asm volatile("" : "+v"(fr_));
        const int row0 = u.pm * 256 + wr * 64 + fr_;
#pragma unroll
        for (int ai = 0; ai < 2; ++ai)
#pragma unroll
            for (int m = 0; m < 4; ++m) {
                const f32x4* sp = (const f32x4*)(ssq + (size_t)(row0 + ai * 128 + m * 16) * 16);
                const f32x4 a = sp[0], b = sp[1], c = sp[2], d = sp[3];
                const float v0 = ((a[0] + a[1]) + (a[2] + a[3]) + (b[0] + b[1]) + (b[2] + b[3])) * (1.0f / 512.0f) + EPS;
                const float v1 = ((c[0] + c[1]) + (c[2] + c[3]) + (d[0] + d[1]) + (d[2] + d[3])) * (1.0f / 512.0f) + EPS;
                const float f = (t == 8) ? rsqrtf(v0) * sqrtf(v1) : rsqrtf(v1);
#pragma unroll
                for (int bj = 0; bj < 2; ++bj)
#pragma unroll
                    for (int n = 0; n < 2; ++n) acc[ai][bj][m][n] *= f;
                asm volatile("" ::: "memory");
            }
    }
    DI void operator()(const f32x4 (&acc)[2][2][4][2], const pg8::Unit& u, int wr, int wc, int fr, int fq) const {
        const int row0 = u.pm * 256 + wr * 64 + fr, col0 = u.pn * 256 + wc * 32 + 4 * fq;
#pragma unroll
        for (int ai = 0; ai < 2; ++ai)
#pragma unroll
            for (int m = 0; m < 4; ++m) {
                const int row = row0 + ai * 128 + m * 16; float ss = 0.f;
#pragma unroll
                for (int bj = 0; bj < 2; ++bj)
#pragma unroll
                    for (int n = 0; n < 2; ++n) {
                        const size_t off = (size_t)row * DM + col0 + bj * 128 + n * 16;
                        f32x4 hv = *(const f32x4*)(hin + off); hv += acc[ai][bj][m][n];
                        *(f32x4*)(hout + off) = hv;
                        u32x2 w = {pk2(hv[0], hv[1]), pk2(hv[2], hv[3])}; if (!dummy) *(u32x2*)(hb + off) = w;
                        ss += (hv[0] * hv[0] + hv[1] * hv[1]) + (hv[2] * hv[2] + hv[3] * hv[3]);
                    }
                ss += __shfl_xor(ss, 16); ss += __shfl_xor(ss, 32);
                if (fq == 0 && !dummy) ssp[(size_t)row * 16 + u.pn * 4 + wc] = ss;
                asm volatile("" ::: "memory");
            }
    }
};
typedef EpiResidT<false> EpiResid;
typedef EpiResidT<true> EpiResidKS;
struct EpiMixA {
    static constexpr bool PERM = true, AFTER_DRAIN = false, KSCALE = false, PREP = true;
    const float* ssp; bf16_t* ymix; bf16_t* xbc; LAS float* tab;
    DI void prep(const pg8::Unit& u, int par, int tid) const { prep_rstd(ssp, tab, u.pm, par, tid); }
    DI void operator()(const f32x4 (&acc)[2][2][4][2], const pg8::Unit& u, int wr, int wc, int fr, int fq, int par) const {
        const int row0 = u.pm * 256 + wr * 64 + fr, colt = wc * 32 + 8 * fq; const int pn = u.pn;
        bf16_t* dst; int ld;
        if (pn < 4) { dst = ymix + pn * 256; ld = 2048; } else { dst = xbc + (pn - 4) * 256; ld = XBCW; }
#pragma unroll
        for (int ai = 0; ai < 2; ++ai)
#pragma unroll
            for (int m = 0; m < 4; ++m) {
                const int row = row0 + ai * 128 + m * 16; const float rs = tab[par * 256 + ai * 128 + wr * 64 + m * 16 + fr];
#pragma unroll
                for (int bj = 0; bj < 2; ++bj) {
                    const f32x4 a = acc[ai][bj][m][0] * rs, b = acc[ai][bj][m][1] * rs;
                    u32x4 w = {pk2(a[0], a[1]), pk2(a[2], a[3]), pk2(b[0], b[1]), pk2(b[2], b[3])};
                    *(u32x4*)(dst + (size_t)row * ld + bj * 128 + colt) = w;
                }
                asm volatile("" ::: "memory");
            }
    }
};
DI u32x4 pk8(const float (&v)[8]) { u32x4 w = {pk2(v[0], v[1]), pk2(v[2], v[3]), pk2(v[4], v[5]), pk2(v[6], v[7])}; return w; }
struct EpiMixB {
    static constexpr bool PERM = true, AFTER_DRAIN = false, KSCALE = false, PREP = true;
    const float* ssp; bf16_t* ymix; bf16_t* kbuf; bf16_t* vbuf; bf16_t* qi; bf16_t* ki; float* misc; const f32x2* ropeA; const f32x2* ropeI; LAS float* tab;
    DI void prep(const pg8::Unit& u, int par, int tid) const { prep_rstd(ssp, tab, u.pm, par, tid); }
    DI void operator()(const f32x4 (&acc)[2][2][4][2], const pg8::Unit& u, int wr, int wc, int fr, int fq, int par) const {
        const int row0 = u.pm * 256 + wr * 64 + fr, pos0 = wc * 32 + 8 * fq; const int pn = u.pn;
#pragma unroll
        for (int ai = 0; ai < 2; ++ai)
#pragma unroll
            for (int m = 0; m < 4; ++m) {
                const int row = row0 + ai * 128 + m * 16; const float rs = tab[par * 256 + ai * 128 + wr * 64 + m * 16 + fr];
                float X[8], Y[8];
#pragma unroll
                for (int e = 0; e < 4; ++e) { X[e] = acc[ai][0][m][0][e] * rs; X[4 + e] = acc[ai][0][m][1][e] * rs; Y[e] = acc[ai][1][m][0][e] * rs; Y[4 + e] = acc[ai][1][m][1][e] * rs; }
                if (pn < 8) {
                    bf16_t* base = (pn < 4) ? ymix + (size_t)row * 2048 + 1024 + pn * 256 : kbuf + (size_t)row * 1024 + (pn - 4) * 256;
                    if (wc == 0) {
                        const int f0 = (8 * fq) & 15; const f32x4* cp = (const f32x4*)(ropeA + (size_t)row * 16 + f0);
                        float ox[8], oy[8];
#pragma unroll
                        for (int e2 = 0; e2 < 4; ++e2) { const f32x4 cs = cp[e2];
                            ox[2 * e2] = X[2 * e2] * cs[0] - Y[2 * e2] * cs[1]; oy[2 * e2] = Y[2 * e2] * cs[0] + X[2 * e2] * cs[1];
                            ox[2 * e2 + 1] = X[2 * e2 + 1] * cs[2] - Y[2 * e2 + 1] * cs[3]; oy[2 * e2 + 1] = Y[2 * e2 + 1] * cs[2] + X[2 * e2 + 1] * cs[3]; }
                        bf16_t* hp = base + (fq >> 1) * 128 + f0;
                        *(u32x4*)hp = pk8(ox); *(u32x4*)(hp + 16) = pk8(oy);
                    } else { *(u32x4*)(base + pos0) = pk8(X); *(u32x4*)(base + 128 + pos0) = pk8(Y); }
                } else if (pn < 12) {
                    bf16_t* base = vbuf + (size_t)row * 1024 + (pn - 8) * 256 + pos0;
                    *(u32x4*)base = pk8(X); *(u32x4*)(base + 128) = pk8(Y);
                } else if (pn < 14) {
                    bf16_t* base = qi + (size_t)row * 512 + (pn - 12) * 256;
                    if (wc == 0) {
                        const f32x4* cp = (const f32x4*)(ropeI + (size_t)row * 8); float ox[8], oy[8];
#pragma unroll
                        for (int e2 = 0; e2 < 4; ++e2) { const f32x4 cs = cp[e2];
                            ox[2 * e2] = X[2 * e2] * cs[0] - Y[2 * e2] * cs[1]; oy[2 * e2] = Y[2 * e2] * cs[0] + X[2 * e2] * cs[1];
                            ox[2 * e2 + 1] = X[2 * e2 + 1] * cs[2] - Y[2 * e2 + 1] * cs[3]; oy[2 * e2 + 1] = Y[2 * e2 + 1] * cs[2] + X[2 * e2 + 1] * cs[3]; }
                        *(u32x4*)(base + fq * 64) = pk8(ox); *(u32x4*)(base + fq * 64 + 8) = pk8(oy);
                    } else { const int q0 = pos0 - 32, hh = (q0 >= 48) ? 1 : 0, d = 16 + q0 - 48 * hh;
                        *(u32x4*)(base + hh * 64 + d) = pk8(X); *(u32x4*)(base + (2 + hh) * 64 + d) = pk8(Y); }
                } else {
                    if (pos0 == 0) {
                        const f32x4* cp = (const f32x4*)(ropeI + (size_t)row * 8); float ox[8], oy[8];
#pragma unroll
                        for (int e2 = 0; e2 < 4; ++e2) { const f32x4 cs = cp[e2];
                            ox[2 * e2] = X[2 * e2] * cs[0] - Y[2 * e2] * cs[1]; oy[2 * e2] = Y[2 * e2] * cs[0] + X[2 * e2] * cs[1];
                            ox[2 * e2 + 1] = X[2 * e2 + 1] * cs[2] - Y[2 * e2 + 1] * cs[3]; oy[2 * e2 + 1] = Y[2 * e2 + 1] * cs[2] + X[2 * e2 + 1] * cs[3]; }
                        *(u32x4*)(ki + (size_t)row * 64) = pk8(ox); *(u32x4*)(ki + (size_t)row * 64 + 8) = pk8(oy);
                    } else if (pos0 < 56) { *(u32x4*)(ki + (size_t)row * 64 + 8 + pos0) = pk8(X); }
                    else if (pos0 < 80) { float* mp = misc + (size_t)row * 32 + (pos0 - 56);
                        *(f32x4*)mp = (f32x4){X[0], X[1], X[2], X[3]}; *(f32x4*)(mp + 4) = (f32x4){X[4], X[5], X[6], X[7]}; }
                }
                asm volatile("" ::: "memory");
            }
    }
};

struct EpiNull {
    static constexpr bool PERM = true, AFTER_DRAIN = false, KSCALE = false, PREP = false;
    float* dst;
    DI void operator()(const f32x4 (&acc)[2][2][4][2], const pg8::Unit& u, int wr, int wc, int fr, int fq) const {
        f32x4 s = {0.f, 0.f, 0.f, 0.f};
#pragma unroll
        for (int ai = 0; ai < 2; ++ai)
#pragma unroll
            for (int bj = 0; bj < 2; ++bj)
#pragma unroll
                for (int m = 0; m < 4; ++m)
#pragma unroll
                    for (int n = 0; n < 2; ++n) s += acc[ai][bj][m][n];
        *(f32x4*)(dst + ((size_t)(u.pm * 22 + u.pn) * 512 + threadIdx.x) * 4) = s;
    }
};

DI void phase_pro(const Ctx& c_in) {
    Ctx c = c_in; { int t_ = c.tid; asm volatile("" : "+v"(t_)); c.tid = t_; c.lane = t_ & 63; }
    const int gw = blockIdx.x * 8 + c.wid, nw = gridDim.x * 8;
    const float* xin = c.x(); const int* posp = c.pos();
    for (int row = gw; row < MTOK; row += nw) {
        const f32x4* src = (const f32x4*)(xin + (size_t)row * DM); float ss = 0.f;
#pragma unroll
        for (int j = 0; j < 4; ++j) {
            const f32x4 v = src[j * 64 + c.lane];
            u32x2 w = {pk2(v[0], v[1]), pk2(v[2], v[3])}; *(u32x2*)(c.hb() + (size_t)row * DM + j * 256 + c.lane * 4) = w;
            ss += (v[0] * v[0] + v[1] * v[1]) + (v[2] * v[2] + v[3] * v[3]);
        }
#pragma unroll
        for (int o = 32; o >= 1; o >>= 1) ss += __shfl_xor(ss, o);
        if (c.lane < 16) c.ssp()[(size_t)row * 16 + c.lane] = (c.lane == 0) ? ss : 0.f;
    }
    const int gt = blockIdx.x * NTHR + c.tid, nt = gridDim.x * NTHR;
    for (int i = gt; i < MTOK * 24; i += nt) {
        const int t = i / 24, f = i % 24;
        const float ang = (float)posp[t] * *(const float __attribute__((address_space(4)))*)(karg_base() + 160 + 4 * f);
        const double rev = (double)ang * 0.15915494309189533577; const double fr = rev - __builtin_rint(rev);
        const float r = (float)fr;
        const f32x2 cs = {__builtin_amdgcn_cosf(r), __builtin_amdgcn_sinf(r)};
        if (f < 16) c.ropeA()[(size_t)t * 16 + f] = cs; else c.ropeI()[(size_t)t * 8 + (f - 16)] = cs;
    }
}

template <int MAP> DI int wmap(int n) {
    if (MAP == 0) return n;
    if (MAP == 1) { const int pn = n >> 8, bj = (n >> 7) & 1, jj = n & 127; return bj * DFF + pn * 128 + jj; }
    const int pn = n >> 8, bj = (n >> 7) & 1, pos = n & 127;
    if (pn < 8) {
        const int base = (pn < 4) ? 2576 : 3600, pp = pn & 3; int head, d;
        if (pos < 16) { head = 2 * pp; d = pos + 16 * bj; }
        else if (pos < 32) { head = 2 * pp + 1; d = (pos - 16) + 16 * bj; }
        else { head = 2 * pp + bj; d = pos; }
        return base + head * 128 + d;
    }
    if (pn < 12) return 4624 + (n - 2048);
    if (pn < 14) {
        const int hA = 4 * (pn - 12); int head, d;
        if (pos < 32) { head = hA + (pos >> 3); d = (pos & 7) + 8 * bj; }
        else { const int q = pos - 32; head = hA + 2 * bj + (q >= 48 ? 1 : 0); d = 16 + (q >= 48 ? q - 48 : q); }
        return 5648 + head * 64 + d;
    }
    if (bj == 0) {
        if (pos < 8) return 6160 + pos;
        if (pos < 56) return 6160 + 8 + pos;
        if (pos < 72) return 2560 + (pos - 56);
        if (pos < 80) return 6224 + (pos - 72);
        return -1;
    }
    return (pos < 8) ? 6168 + pos : -1;
}
template <int MAP> DI void convert_w(const Ctx& c_in, const float* W, int K, int Nsrc, bf16_t* Bt, int Nout, const float* gain, int klim, float scale) {
    Ctx c = c_in; { int t_ = c.tid; asm volatile("" : "+v"(t_)); c.tid = t_; c.lane = t_ & 63; }
    LAS float* tile = (LAS float*)c.lds;
    const int nkt = K / 64, ntiles = (Nout / 64) * nkt;
    for (int t = blockIdx.x; t < ntiles; t += gridDim.x) {
        const int n0 = (t / nkt) * 64, k0 = (t % nkt) * 64;
        const int nl = c.tid & 63, src = wmap<MAP>(n0 + nl);
#pragma unroll
        for (int i = 0; i < 8; ++i) {
            const int kl = (c.tid >> 6) + 8 * i, k = k0 + kl;
            float v = (src >= 0) ? W[(size_t)k * Nsrc + src] : 0.f;
            const float g = (gain != nullptr && k < klim) ? gain[k] : 1.f;
            tile[kl * 65 + nl] = v * g * scale;
        }
        __syncthreads();
#pragma unroll
        for (int i = 0; i < 4; ++i) {
            const int n2 = (c.tid >> 5) + 16 * i, kl = (c.tid & 31) * 2;
            *(unsigned*)(Bt + (size_t)(n0 + n2) * K + k0 + kl) = pk2(tile[kl * 65 + n2], tile[(kl + 1) * 65 + n2]);
        }
        __syncthreads();
    }
}


#define WRLANE(dst, sval, ln) asm volatile("s_nop 3\n\tv_writelane_b32 %0, %1, %2" : "+v"(dst) : "s"(sval), "n"(ln))
DI unsigned ord_key(float v) { const unsigned u = __float_as_uint(v); return u ^ ((u & 0x80000000u) ? 0xffffffffu : 0x80000000u); }
DI void sel_load_q(const Ctx& c, int u, int c32, int hi, bf16x8 (&af)[2][4], float (&wv)[2][4][4]) {
    const int t8 = (SEQ / 8 - 1) - (u >> 2), b = u & 3; const size_t tok0 = (size_t)b * SEQ + t8 * 8;
#pragma unroll
    for (int mt = 0; mt < 2; ++mt) {
        const size_t tq = tok0 + 4 * mt + (c32 >> 3);
#pragma unroll
        for (int ks = 0; ks < 4; ++ks) af[mt][ks] = *(const bf16x8*)(c.qi() + tq * 512 + (c32 & 7) * 64 + 16 * ks + 8 * hi);
#pragma unroll
        for (int tl = 0; tl < 4; ++tl) { const f32x4 w4 = *(const f32x4*)(c.misc() + (tok0 + 4 * mt + tl) * 32 + 16 + 4 * hi);
            wv[mt][tl][0] = w4[0]; wv[mt][tl][1] = w4[1]; wv[mt][tl][2] = w4[2]; wv[mt][tl][3] = w4[3]; }
    }
}
DI void sel_load_kgroup(const bf16_t* kbase, int kt0, int nkt, bf16x8 (&b)[4][4]) {
#pragma unroll
    for (int j = 0; j < 4; ++j) { const int kt = (kt0 + 8 * j < nkt) ? kt0 + 8 * j : nkt - 1;
#pragma unroll
        for (int ks = 0; ks < 4; ++ks) b[j][ks] = *(const bf16x8*)(kbase + (size_t)kt * 32 * 64 + 16 * ks); }
}
DI void sel_score_group(const bf16x8 (&af)[2][4], const float (&wv)[2][4][4], const bf16x8 (&b)[4][4], LAS float* sc, int kt0, int nkt, int c32, int hi) {
#pragma unroll
    for (int j = 0; j < 4; ++j) { const int kt = kt0 + 8 * j;
        if (kt < nkt) {
            const int s0 = kt * 32;
#pragma unroll
            for (int mt = 0; mt < 2; ++mt) {
                f32x16 acc = {};
#pragma unroll
                for (int ks = 0; ks < 4; ++ks) acc = MFMA32(af[mt][ks], b[j][ks], acc);
                float tot[4];
#pragma unroll
                for (int tl = 0; tl < 4; ++tl) {
                    float p = 0.f;
#pragma unroll
                    for (int jj = 0; jj < 4; ++jj) p += wv[mt][tl][jj] * fmaxf(acc[4 * tl + jj], 0.f);
                    const auto rr = __builtin_amdgcn_permlane32_swap(__float_as_uint(p), __float_as_uint(p), false, false);
                    tot[tl] = (__uint_as_float(rr[0]) + __uint_as_float(rr[1])) + 0.0f;
                }
                const int ql = 4 * mt + 2 * hi;
                sc[ql * 4096 + s0 + c32] = hi ? tot[2] : tot[0];
                sc[(ql + 1) * 4096 + s0 + c32] = hi ? tot[3] : tot[1];
            }
        } }
}
DI void phase_select(const Ctx& c_in) {
    Ctx c = c_in; { int t_ = c.tid; asm volatile("" : "+v"(t_)); c.tid = t_; c.lane = t_ & 63; }
    LAS float* sc = (LAS float*)c.lds;
    const int lane = c.lane, wid = c.wid, c32 = lane & 31, hi = lane >> 5;
    bf16x8 af[2][4]; float wv[2][4][4];
    if ((int)blockIdx.x < NB * (SEQ / 8)) sel_load_q(c, blockIdx.x, c32, hi, af, wv);
    for (int u = blockIdx.x; u < NB * (SEQ / 8); u += gridDim.x) {
        const int t8 = (SEQ / 8 - 1) - (u >> 2), b = u & 3, t0 = t8 * 8;
        const int nkt = (t0 + 7) / 32 + 1;
        const bf16_t* kbase = c.ki() + ((size_t)b * SEQ + c32) * 64 + 8 * hi;
        {
            bf16x8 bA[4][4], bB[4][4];
            const int ng = (nkt - wid + 31) / 32;
            sel_load_kgroup(kbase, wid, nkt, bA);
            for (int gi = 0; gi < ng; gi += 2) {
                sel_load_kgroup(kbase, wid + 32 * (gi + 1), nkt, bB);
                sel_score_group(af, wv, bA, sc, wid + 32 * gi, nkt, c32, hi);
                sel_load_kgroup(kbase, wid + 32 * (gi + 2), nkt, bA);
                sel_score_group(af, wv, bB, sc, wid + 32 * (gi + 1), nkt, c32, hi);
            }
        }
        if (u + (int)gridDim.x < NB * (SEQ / 8)) sel_load_q(c, u + gridDim.x, c32, hi, af, wv);
        __syncthreads();
        {
            int lane_ = c.lane; asm volatile("" : "+v"(lane_)); const int lane = lane_;
            const int t = t0 + wid; unsigned mlo = 0u, mhi = 0u;
            if (t < 256) {
#pragma unroll
                for (int r = 0; r < 64; ++r) {
                    const unsigned long long bal = __ballot(r * 64 + lane <= t);
                    WRLANE(mlo, (unsigned)bal, r); WRLANE(mhi, (unsigned)(bal >> 32), r);
                    __builtin_amdgcn_sched_barrier(0);
                }
            } else {
                unsigned key[64];
                const int nreg = (t >> 6) + 1;
#pragma unroll
                for (int r = 0; r < 64; ++r) { const int s = r * 64 + lane; const float v = sc[wid * 4096 + s]; key[r] = (s <= t) ? ord_key(v) : 0u; }
#ifndef PROBE_BITS
#define PROBE_BITS 1
#endif
                unsigned T = 0u; int cge = 4096;
                for (int rep = 0; rep < PROBE_BITS; ++rep) { T = 0u;
                for (int bit = 31; bit >= 0; --bit) {
                    const unsigned cand = T | (1u << bit); int cnt = 0;
#pragma unroll
                    for (int g = 0; g < 8; ++g) {
                        if (g * 8 < nreg) {
                            { unsigned long long m0 = __ballot(key[g * 8] >= cand), m1 = __ballot(key[g * 8 + 1] >= cand), m2 = __ballot(key[g * 8 + 2] >= cand), m3 = __ballot(key[g * 8 + 3] >= cand),
                                                 m4 = __ballot(key[g * 8 + 4] >= cand), m5 = __ballot(key[g * 8 + 5] >= cand), m6 = __ballot(key[g * 8 + 6] >= cand), m7 = __ballot(key[g * 8 + 7] >= cand);
                              asm volatile("" : "+s"(m0), "+s"(m1), "+s"(m2), "+s"(m3), "+s"(m4), "+s"(m5), "+s"(m6), "+s"(m7));
                              cnt += (__popcll(m0) + __popcll(m1)) + (__popcll(m2) + __popcll(m3)) + ((__popcll(m4) + __popcll(m5)) + (__popcll(m6) + __popcll(m7))); }
                        }
                        __builtin_amdgcn_sched_barrier(0);
                    }
                    if (cnt >= 256) { T = cand; cge = cnt; if (cnt == 256) break; }
                } }
#ifndef PROBE_FINAL
#define PROBE_FINAL 1
#endif
                for (int repf = 0; repf < PROBE_FINAL; ++repf) {
                if (cge == 256) {
#pragma unroll
                    for (int g = 0; g < 8; ++g) {
                        if (g * 8 < nreg) {
#pragma unroll
                            for (int rr = 0; rr < 8; ++rr) { const unsigned long long word = __ballot(key[g * 8 + rr] >= T);
                                WRLANE(mlo, (unsigned)word, g * 8 + rr); WRLANE(mhi, (unsigned)(word >> 32), g * 8 + rr); }
                        }
                        __builtin_amdgcn_sched_barrier(0);
                    }
                } else {
                int cgt = 0;
#pragma unroll
                for (int g = 0; g < 8; ++g) {
#pragma unroll
                    for (int rr = 0; rr < 8; ++rr) cgt += __popcll(__ballot(key[g * 8 + rr] > T));
                    __builtin_amdgcn_sched_barrier(0);
                }
                int need = 256 - cgt;
#pragma unroll
                for (int r = 0; r < 64; ++r) {
                    const unsigned long long gt = __ballot(key[r] > T); unsigned long long eq = __ballot(key[r] == T), take;
                    const int ne = __popcll(eq);
                    if (ne <= need) { take = eq; need -= ne; }
                    else { take = 0ull; while (need > 0) { const unsigned long long low = eq & (0ull - eq); take |= low; eq ^= low; --need; } }
                    const unsigned long long word = gt | take;
                    WRLANE(mlo, (unsigned)word, r); WRLANE(mhi, (unsigned)(word >> 32), r);
                    __builtin_amdgcn_sched_barrier(0);
                }
                }
                }
            }
            u32x2 w = {mlo, mhi};
            *(u32x2*)(c.mask() + ((size_t)b * SEQ + t) * 128 + 2 * lane) = w;
        }
        __syncthreads();
    }
}

constexpr int VT_PITCH = 144;
constexpr int ATT_K_OFF = 0, ATT_V_OFF = 16384;
DI void phase_attn(const Ctx& c_in, const int dummy) {
    Ctx c = c_in; { int t_ = c.tid; asm volatile("" : "+v"(t_)); c.tid = t_; c.lane = t_ & 63; }
    LAS unsigned char* Kl = c.lds + ATT_K_OFF; LAS unsigned char* Vl = c.lds + ATT_V_OFF;
    const int lane = c.lane, wid = c.wid, tid = c.tid, c32 = lane & 31, hi = lane >> 5;
    constexpr float C2 = 0.08838834764831845f * 1.4426950408889634f;
    const float NEG = -__builtin_inff();
    for (int u = blockIdx.x; u < NB * 8 * 8; u += gridDim.x) {
        const int x = u & 7, hd = (u >> 3) & 7, b = u >> 6;
        for (int half = 0; half < 2; ++half) {
            const int qb = half ? 15 - x : x, P0 = qb * 256; const size_t tq = (size_t)b * SEQ + P0 + 32 * wid + c32;
            bf16_t* qptr = c.ymix() + tq * 2048 + 1024 + hd * 128;
            bf16x8 qr[8];
#pragma unroll
            for (int d0 = 0; d0 < 8; ++d0) qr[d0] = *(const bf16x8*)(qptr + 16 * d0 + 8 * hi);
            float m_run = -1e30f, l_run = 0.f; f32x16 o[4] = {};
            const int ntiles = P0 / 64 + 4, qmax = P0 + 32 * wid + 31;
            const bf16_t* kbase = c.kbuf() + (size_t)b * SEQ * 1024 + hd * 128; const bf16_t* vbase = c.vbuf() + (size_t)b * SEQ * 1024 + hd * 128;
            const unsigned* mrow = c.mask() + tq * 128;
            bf16x8 sk0, sk1, sv0, sv1;
            {
                sk0 = *(const bf16x8*)(kbase + (size_t)(tid >> 4) * 1024 + (tid & 15) * 8); sk1 = *(const bf16x8*)(kbase + (size_t)(32 + (tid >> 4)) * 1024 + (tid & 15) * 8);
                sv0 = *(const bf16x8*)(vbase + (size_t)lane * 1024 + 16 * wid); sv1 = *(const bf16x8*)(vbase + (size_t)lane * 1024 + 16 * wid + 8);
            }
            u32x2 mw = *(const u32x2*)(mrow);
            for (int j = 0; j < ntiles; ++j) {
                __syncthreads();
                {
                    const int key = tid >> 4, ch = tid & 15;
                    *(LAS bf16x8*)(Kl + key * 256 + ((ch * 16) ^ ((key & 7) << 4))) = sk0;
                    *(LAS bf16x8*)(Kl + (key + 32) * 256 + ((ch * 16) ^ ((key & 7) << 4))) = sk1;
#pragma unroll
                    for (int e = 0; e < 8; ++e) { *(LAS short*)(Vl + (16 * wid + e) * VT_PITCH + lane * 2) = sv0[e]; *(LAS short*)(Vl + (16 * wid + 8 + e) * VT_PITCH + lane * 2) = sv1[e]; }
                }
                __syncthreads();
                const u32x2 mcur = mw;
                if (j + 1 < ntiles) {
                    const size_t k0 = (size_t)(j + 1) * 64;
                    sk0 = *(const bf16x8*)(kbase + (k0 + (tid >> 4)) * 1024 + (tid & 15) * 8); sk1 = *(const bf16x8*)(kbase + (k0 + 32 + (tid >> 4)) * 1024 + (tid & 15) * 8);
                    sv0 = *(const bf16x8*)(vbase + (k0 + lane) * 1024 + 16 * wid); sv1 = *(const bf16x8*)(vbase + (k0 + lane) * 1024 + 16 * wid + 8);
                    mw = *(const u32x2*)(mrow + 2 * (j + 1));
                }
                if (j * 64 <= qmax) {
                    f32x16 p0 = {}, p1 = {};
#pragma unroll
                    for (int d0 = 0; d0 < 8; ++d0) {
                        const int ch = 2 * d0 + hi;
                        const bf16x8 a0 = *(const LAS bf16x8*)(Kl + c32 * 256 + ((ch * 16) ^ ((c32 & 7) << 4)));
                        const bf16x8 a1 = *(const LAS bf16x8*)(Kl + (c32 + 32) * 256 + ((ch * 16) ^ ((c32 & 7) << 4)));
                        p0 = MFMA32(a0, qr[d0], p0); p1 = MFMA32(a1, qr[d0], p1);
                    }
                    const unsigned w0 = mcur[0] >> (4 * hi), w1 = mcur[1] >> (4 * hi);
                    float tmax = NEG;
#pragma unroll
                    for (int r = 0; r < 16; ++r) {
                        const unsigned bit = 1u << ((r & 3) + 8 * (r >> 2));
                        p0[r] = (w0 & bit) ? p0[r] : NEG; p1[r] = (w1 & bit) ? p1[r] : NEG;
                        tmax = fmaxf(tmax, fmaxf(p0[r], p1[r]));
                    }
                    tmax = fmaxf(tmax, __shfl_xor(tmax, 32));
                    const float mn = fmaxf(m_run, tmax); const float alpha = __builtin_amdgcn_exp2f((m_run - mn) * C2); m_run = mn;
                    const float mnl = -mn * C2; float ps = 0.f;
#pragma unroll
                    for (int r = 0; r < 16; ++r) { p0[r] = __builtin_amdgcn_exp2f(fmaf(p0[r], C2, mnl)); p1[r] = __builtin_amdgcn_exp2f(fmaf(p1[r], C2, mnl)); ps += p0[r] + p1[r]; }
                    l_run = l_run * alpha + ps;
                    if (!__all(alpha == 1.0f)) {
#pragma unroll
                        for (int db = 0; db < 4; ++db)
#pragma unroll
                            for (int r = 0; r < 16; ++r) o[db][r] *= alpha;
                    }
                    bf16x8 pb[4];
                    pb[0] = pack8((f32x4){p0[0], p0[1], p0[2], p0[3]}, (f32x4){p0[4], p0[5], p0[6], p0[7]});
                    pb[1] = pack8((f32x4){p0[8], p0[9], p0[10], p0[11]}, (f32x4){p0[12], p0[13], p0[14], p0[15]});
                    pb[2] = pack8((f32x4){p1[0], p1[1], p1[2], p1[3]}, (f32x4){p1[4], p1[5], p1[6], p1[7]});
                    pb[3] = pack8((f32x4){p1[8], p1[9], p1[10], p1[11]}, (f32x4){p1[12], p1[13], p1[14], p1[15]});
#pragma unroll
                    for (int db = 0; db < 4; ++db)
#pragma unroll
                        for (int ks = 0; ks < 4; ++ks) {
                            const LAS unsigned char* vp = Vl + (32 * db + c32) * VT_PITCH + (16 * ks + 4 * hi) * 2;
                            const s16x4 lo = *(const LAS s16x4*)vp, hh = *(const LAS s16x4*)(vp + 16);
                            const bf16x8 a = {lo[0], lo[1], lo[2], lo[3], hh[0], hh[1], hh[2], hh[3]};
                            o[db] = MFMA32(a, pb[ks], o[db]);
                        }
                }
            }
            l_run += __shfl_xor(l_run, 32);
            const float rl = 1.0f / l_run;
#pragma unroll
            for (int db = 0; db < 4; ++db)
#pragma unroll
                for (int g = 0; g < 4; ++g) {
                    u32x2 w = {pk2(o[db][4 * g] * rl, o[db][4 * g + 1] * rl), pk2(o[db][4 * g + 2] * rl, o[db][4 * g + 3] * rl)};
                    *(u32x2*)((dummy ? qptr - 1024 : qptr) + 32 * db + 8 * g + 4 * hi) = w;
                }
        }
    }
}

template <int NT> DI void conv_seg(const bf16_t* xbc, size_t tok_first, int pos_first, int cidx, const float* cw, const float* cb, float (&out)[NT][8]) {
    u32x4 rows[NT + 3];
#pragma unroll
    for (int i = 0; i < NT + 3; ++i) {
        const int off = i - 3, offc = (off < -pos_first) ? -pos_first : off;
        const u32x4 v = *(const u32x4*)(xbc + (size_t)((long)tok_first + offc) * XBCW + cidx);
        const bool ok = (pos_first + off >= 0);
        rows[i] = (u32x4){ok ? v[0] : 0u, ok ? v[1] : 0u, ok ? v[2] : 0u, ok ? v[3] : 0u};
    }
    float w[4][8], bias[8];
#pragma unroll
    for (int k = 0; k < 4; ++k) { const f32x4 w0 = *(const f32x4*)(cw + k * XBCW + cidx), w1 = *(const f32x4*)(cw + k * XBCW + cidx + 4);
        w[k][0] = w0[0]; w[k][1] = w0[1]; w[k][2] = w0[2]; w[k][3] = w0[3]; w[k][4] = w1[0]; w[k][5] = w1[1]; w[k][6] = w1[2]; w[k][7] = w1[3]; }
    { const f32x4 b0 = *(const f32x4*)(cb + cidx), b1 = *(const f32x4*)(cb + cidx + 4);
      bias[0] = b0[0]; bias[1] = b0[1]; bias[2] = b0[2]; bias[3] = b0[3]; bias[4] = b1[0]; bias[5] = b1[1]; bias[6] = b1[2]; bias[7] = b1[3]; }
#pragma unroll
    for (int j = 0; j < NT; ++j)
#pragma unroll
        for (int e = 0; e < 8; ++e) {
            float a = bias[e];
#pragma unroll
            for (int k = 0; k < 4; ++k) { const unsigned wd = rows[j + k][e >> 1]; a += w[k][e] * ((e & 1) ? bfhi(wd) : bflo(wd)); }
            out[j][e] = silu_f(a);
        }
}
constexpr int SSD_PITCH = 264;
DI void ssd_dt_scan(const Ctx& c, LAS float* dtl, LAS float* acs, size_t tok0, int h, const float* dt_bias, const float* a_log) {
    if (c.tid < 256) {
        const float v = c.misc()[(tok0 + c.tid) * 32 + h] + dt_bias[h];
        const float sp = fmaxf(v, 0.f) + log1pf(__expf(-fabsf(v)));
        dtl[c.tid] = sp;
    }
    __syncthreads();
    if (c.wid == 0) {
        const float a = -__expf(a_log[h]);
        const float a0 = dtl[4 * c.lane] * a, a1 = dtl[4 * c.lane + 1] * a, a2 = dtl[4 * c.lane + 2] * a, a3 = dtl[4 * c.lane + 3] * a;
        const float s1 = a0, s2 = s1 + a1, s3 = s2 + a2, s4 = s3 + a3; float tot = s4;
#pragma unroll
        for (int off = 1; off < 64; off <<= 1) { const float n = __shfl_up(tot, off); if (c.lane >= off) tot += n; }
        const float base = tot - s4;
        acs[4 * c.lane] = base + s1; acs[4 * c.lane + 1] = base + s2; acs[4 * c.lane + 2] = base + s3; acs[4 * c.lane + 3] = base + s4;
    }
    __syncthreads();
}
DI void phase_ssd_states(const Ctx& c_in, const float* cw, const float* cb, const float* dt_bias, const float* a_log) {
    Ctx c = c_in; { int t_ = c.tid; asm volatile("" : "+v"(t_)); c.tid = t_; c.lane = t_ & 63; }
    LAS bf16_t* XT = (LAS bf16_t*)c.lds;
    LAS bf16_t* BT = (LAS bf16_t*)(c.lds + 64 * SSD_PITCH * 2);
    LAS float* dtl = (LAS float*)(c.lds + 192 * SSD_PITCH * 2); LAS float* acs = dtl + 256;
    const int lane = c.lane, wid = c.wid, tid = c.tid, c32 = lane & 31, hi = lane >> 5;
    for (int u = blockIdx.x; u < 1024; u += gridDim.x) {
        const int h = u & 15, ch = (u >> 4) & 15, b = u >> 8, g = h >> 3; const size_t tok0 = (size_t)b * SEQ + ch * 256;
        ssd_dt_scan(c, dtl, acs, tok0, h, dt_bias, a_log);
        const float alast = acs[255];
        {
            const int oct = tid & 7, l0 = (tid >> 3) * 4; float v[4][8];
            conv_seg<4>(c.xbc(), tok0 + l0, ch * 256 + l0, h * 64 + oct * 8, cw, cb, v);
            float sc[4];
#pragma unroll
            for (int j = 0; j < 4; ++j) sc[j] = dtl[l0 + j] * __expf(alast - acs[l0 + j]);
#pragma unroll
            for (int e = 0; e < 8; ++e) { u32x2 w = {pk2(v[0][e] * sc[0], v[1][e] * sc[1]), pk2(v[2][e] * sc[2], v[3][e] * sc[3])}; *(LAS u32x2*)(XT + (oct * 8 + e) * SSD_PITCH + l0) = w; }
        }
        {
            const int oct = tid & 15, l0 = (tid >> 4) * 8; float v[8][8];
            conv_seg<8>(c.xbc(), tok0 + l0, ch * 256 + l0, 1024 + g * 128 + oct * 8, cw, cb, v);
#pragma unroll
            for (int e = 0; e < 8; ++e) { u32x4 w = {pk2(v[0][e], v[1][e]), pk2(v[2][e], v[3][e]), pk2(v[4][e], v[5][e]), pk2(v[6][e], v[7][e])}; *(LAS u32x4*)(BT + (oct * 8 + e) * SSD_PITCH + l0) = w; }
        }
        __syncthreads();
        const int pb = wid >> 2, nb = wid & 3; f32x16 acc = {};
#pragma unroll
        for (int ks = 0; ks < 16; ++ks) {
            const bf16x8 a = *(const LAS bf16x8*)(XT + (32 * pb + c32) * SSD_PITCH + 16 * ks + 8 * hi);
            const bf16x8 bb = *(const LAS bf16x8*)(BT + (32 * nb + c32) * SSD_PITCH + 16 * ks + 8 * hi);
            acc = MFMA32(a, bb, acc);
        }
        float* st = c.states() + (size_t)u * 8192;
#pragma unroll
        for (int r = 0; r < 16; ++r) st[(32 * pb + crow(r, hi)) * 128 + 32 * nb + c32] = acc[r];
        if (tid == 0) c.cdec()[u] = __expf(alast);
        __syncthreads();
    }
}
DI void phase_ssd_out(const Ctx& c_in, const float* cw, const float* cb, const float* dt_bias, const float* a_log, const float* d_skip, const int dummy) {
    Ctx c = c_in; { int t_ = c.tid; asm volatile("" : "+v"(t_)); c.tid = t_; c.lane = t_ & 63; }
    LAS unsigned char* Bn = c.lds;
    LAS bf16_t* XT = (LAS bf16_t*)(c.lds + 65536);
    LAS bf16_t* Hs = (LAS bf16_t*)(c.lds + 65536 + 64 * SSD_PITCH * 2);
    LAS float* dtl = (LAS float*)(c.lds + 65536 + 64 * SSD_PITCH * 2 + 64 * 136 * 2); LAS float* acs = dtl + 256;
    const int wid = c.wid;
    for (int u = blockIdx.x; u < 1024; u += gridDim.x) {
        int tid_ = c.tid; asm volatile("" : "+v"(tid_)); const int tid = tid_, lane = tid & 63, c32 = lane & 31, hi = lane >> 5;
        const int h = u & 15, ch = (u >> 4) & 15, b = u >> 8, g = h >> 3; const size_t tok0 = (size_t)b * SEQ + ch * 256;
        ssd_dt_scan(c, dtl, acs, tok0, h, dt_bias, a_log);
        {
            const int oct = tid & 15;
#pragma unroll 1
            for (int hf = 0; hf < 2; ++hf) { const int l0 = (tid >> 4) * 8 + 4 * hf; float v[4][8];
                conv_seg<4>(c.xbc(), tok0 + l0, ch * 256 + l0, 1280 + g * 128 + oct * 8, cw, cb, v);
#pragma unroll
                for (int j = 0; j < 4; ++j) { const int l = l0 + j;
                    *(LAS bf16x8*)(Bn + l * 256 + ((oct * 16) ^ ((l & 7) << 4))) = pack8((f32x4){v[j][0], v[j][1], v[j][2], v[j][3]}, (f32x4){v[j][4], v[j][5], v[j][6], v[j][7]}); } }
        }
        {
            const int oct = tid & 7, l0 = (tid >> 3) * 4; float v[4][8];
            conv_seg<4>(c.xbc(), tok0 + l0, ch * 256 + l0, h * 64 + oct * 8, cw, cb, v);
#pragma unroll
            for (int e = 0; e < 8; ++e) { u32x2 w = {pk2(v[0][e], v[1][e]), pk2(v[2][e], v[3][e])}; *(LAS u32x2*)(XT + (oct * 8 + e) * SSD_PITCH + l0) = w; }
        }
        {
            const int p = tid >> 3, n0 = (tid & 7) * 16; f32x4 hs[4] = {};
            for (int cc = 0; cc < ch; ++cc) {
                const int u2 = ((b * 16 + cc) << 4) + h; const float* sp = c.states() + (size_t)u2 * 8192 + p * 128 + n0; const float dec = c.cdec()[u2];
#pragma unroll
                for (int q = 0; q < 4; ++q) hs[q] = hs[q] * dec + *(const f32x4*)(sp + 4 * q);
            }
            *(LAS bf16x8*)(Hs + p * 136 + n0) = pack8(hs[0], hs[1]); *(LAS bf16x8*)(Hs + p * 136 + n0 + 8) = pack8(hs[2], hs[3]);
        }
        __syncthreads();
        const int l = 32 * wid + c32; bf16x8 qr[8];
#pragma unroll
        for (int ks = 0; ks < 8; ++ks) qr[ks] = *(const LAS bf16x8*)(Bn + l * 256 + (((2 * ks + hi) * 16) ^ ((l & 7) << 4)));
        __syncthreads();
        {
            const int oct = tid & 15;
#pragma unroll 1
            for (int hf = 0; hf < 2; ++hf) { const int l0 = (tid >> 4) * 8 + 4 * hf; float v[4][8];
                conv_seg<4>(c.xbc(), tok0 + l0, ch * 256 + l0, 1024 + g * 128 + oct * 8, cw, cb, v);
#pragma unroll
                for (int j = 0; j < 4; ++j) { const int l2 = l0 + j;
                    *(LAS bf16x8*)(Bn + l2 * 256 + ((oct * 16) ^ ((l2 & 7) << 4))) = pack8((f32x4){v[j][0], v[j][1], v[j][2], v[j][3]}, (f32x4){v[j][4], v[j][5], v[j][6], v[j][7]}); } }
        }
        __syncthreads();
        const float acs_l = acs[l], dsk = d_skip[h];
        f32x16 o[2] = {};
        for (int j = 0; j <= wid; ++j) {
            f32x16 p = {};
#pragma unroll
            for (int ks = 0; ks < 8; ++ks) {
                const int row = 32 * j + c32, chn = 2 * ks + hi;
                const bf16x8 a = *(const LAS bf16x8*)(Bn + row * 256 + ((chn * 16) ^ ((row & 7) << 4)));
                p = MFMA32(a, qr[ks], p);
            }
#pragma unroll
            for (int r = 0; r < 16; ++r) {
                const int s = 32 * j + crow(r, hi);
                float v = p[r] * __expf(acs_l - acs[s]) * dtl[s];
                v = (s <= l) ? v : 0.f;
                p[r] = (s == l) ? v + dsk : v;
            }
            bf16x8 pb[2];
            pb[0] = pack8((f32x4){p[0], p[1], p[2], p[3]}, (f32x4){p[4], p[5], p[6], p[7]});
            pb[1] = pack8((f32x4){p[8], p[9], p[10], p[11]}, (f32x4){p[12], p[13], p[14], p[15]});
#pragma unroll
            for (int pk = 0; pk < 2; ++pk)
#pragma unroll
                for (int ks = 0; ks < 2; ++ks) {
                    const LAS bf16_t* xp = XT + (32 * pk + c32) * SSD_PITCH + 32 * j + 16 * ks + 4 * hi;
                    const s16x4 lo = *(const LAS s16x4*)xp, hh = *(const LAS s16x4*)(xp + 8);
                    const bf16x8 a = {lo[0], lo[1], lo[2], lo[3], hh[0], hh[1], hh[2], hh[3]};
                    o[pk] = MFMA32(a, pb[ks], o[pk]);
                }
        }
        {
            f32x16 o2[2] = {};
#pragma unroll
            for (int pk = 0; pk < 2; ++pk)
#pragma unroll
                for (int ks = 0; ks < 8; ++ks) {
                    const bf16x8 a = *(const LAS bf16x8*)(Hs + (32 * pk + c32) * 136 + 16 * ks + 8 * hi);
                    o2[pk] = MFMA32(a, qr[ks], o2[pk]);
                }
            const float el = __expf(acs_l);
#pragma unroll
            for (int pk = 0; pk < 2; ++pk)
#pragma unroll
                for (int r = 0; r < 16; ++r) o[pk][r] += el * o2[pk][r];
        }
        bf16_t* zrow = c.ymix() + (tok0 + l) * 2048 + h * 64; float ss = 0.f;
#pragma unroll
        for (int pk = 0; pk < 2; ++pk)
#pragma unroll
            for (int gq = 0; gq < 4; ++gq) {
                bf16_t* zp = zrow + 32 * pk + 8 * gq + 4 * hi; const u32x2 zz = *(const u32x2*)zp;
                const float y0 = o[pk][4 * gq] * silu_f(bflo(zz[0])), y1 = o[pk][4 * gq + 1] * silu_f(bfhi(zz[0]));
                const float y2 = o[pk][4 * gq + 2] * silu_f(bflo(zz[1])), y3 = o[pk][4 * gq + 3] * silu_f(bfhi(zz[1]));
                u32x2 w = {pk2(y0, y1), pk2(y2, y3)};
                const float r0 = bflo(w[0]), r1 = bfhi(w[0]), r2 = bflo(w[1]), r3 = bfhi(w[1]);
                ss += (r0 * r0 + r1 * r1) + (r2 * r2 + r3 * r3);
                *(u32x2*)(dummy ? c.hb() + (tok0 + l) * 1024 + h * 64 + 32 * pk + 8 * gq + 4 * hi : zp) = w;
            }
        ss += __shfl_xor(ss, 32);
        if (hi == 0) c.ssq()[(tok0 + l) * 16 + h] = ss;
        __syncthreads();
    }
}
DI void phase_final(const Ctx& c_in, const float* gain) {
    Ctx c = c_in; { int t_ = c.tid; asm volatile("" : "+v"(t_)); c.tid = t_; c.lane = t_ & 63; }
    const int gt = blockIdx.x * NTHR + c.tid, nt = gridDim.x * NTHR; float* hout = c.h();
    for (int i = gt; i < MTOK * 256; i += nt) {
        const int row = i >> 8, c4 = (i & 255) * 4; const float rs = row_rstd(c.ssp(), row);
        f32x4* p = (f32x4*)(hout + (size_t)row * DM + c4); const f32x4 g = *(const f32x4*)(gain + c4);
        *p = *p * rs * g;
    }
}

constexpr int PH_PER_LAYER = 12, N_PHASES = 2 + 2 * PH_PER_LAYER;
#ifndef PH_MASK
#define PH_MASK 0xffffffffu
#endif
#define KIND(q) (((PH_MASK) >> (q)) & 1u)
#define IN(k) (lo <= (k) && (k) < hi)
DI Ctx launder_ctx(const Ctx& c0) { Ctx c = c0; asm volatile("" : "+s"(c.ws)); return c; }
#define LC() launder_ctx(c0)
DI XcdBarrier make_bar(const Ctx& c0) { XcdBarrier b; unsigned char* w = c0.ws; asm volatile("" : "+s"(w)); b.bar = (unsigned*)(w + WS_CTL); b.x = xb_xcc_id(); b.st = (volatile LAS unsigned*)(c0.lds + LDS_BAR_OFF); return b; }
#define SEAM(k) do { if (IN(k) && IN((k) + 1)) xcd_barrier(make_bar(c0)); } while (0)
#ifndef PROBE_WC
#define PROBE_WC 1
#endif
#ifndef PROBE_FFNIN
#define PROBE_FFNIN 1
#endif
#ifndef PROBE_D1
#define PROBE_D1 1
#endif
#ifndef PROBE_SEL
#define PROBE_SEL 1
#endif
#ifndef PROBE_ATTN
#define PROBE_ATTN 0
#endif
#ifndef PROBE_S0
#define PROBE_S0 1
#endif
#ifndef PROBE_S1
#define PROBE_S1 1
#endif
#ifndef PROBE_S3
#define PROBE_S3 0
#endif
template <int layer> DI void layer_phases(const Ctx& c0, const int lo, const int hi) {
    const int G = (int)gridDim.x, bx = (int)blockIdx.x;
    constexpr int pb = 1 + layer * PH_PER_LAYER;
#define LP(i, stride) (argp(i) + (size_t)layer * (stride))
    if (KIND(1) && IN(pb + 0)) for (int rep = 0; rep < PROBE_WC; ++rep) {
        const Ctx c = LC();
        convert_w<1>(LC(), LP(3, (size_t)DM * NFFIN), DM, NFFIN, c.wb() + WB_1IN, NFFIN, LP(2, DM), DM, 1.0f);
        convert_w<0>(LC(), LP(4, (size_t)DFF * DM), DFF, DM, c.wb() + WB_1OUT, DM, nullptr, 0, 0.5f);
        convert_w<2>(LC(), LP(6, (size_t)DM * DINPROJ), DM, DINPROJ, c.wb() + WB_MIXB, NMIXB, LP(5, DM), DM, 1.0f);
        convert_w<0>(LC(), LP(6, (size_t)DM * DINPROJ), DM, DINPROJ, c.wb() + WB_MIXA, NMIXA, LP(5, DM), DM, 1.0f);
        convert_w<0>(LC(), LP(13, (size_t)2048 * DM), 2048, DM, c.wb() + WB_MO, DM, LP(12, DM), DM, 1.0f);
        convert_w<1>(LC(), LP(15, (size_t)DM * NFFIN), DM, NFFIN, c.wb() + WB_2IN, NFFIN, LP(14, DM), DM, 1.0f);
        convert_w<0>(LC(), LP(16, (size_t)DFF * DM), DFF, DM, c.wb() + WB_2OUT, DM, nullptr, 0, 0.5f);
    }
    SEAM(pb + 0);
#if PROBE_FFNIN > 1
    if (KIND(2) && IN(pb + 1)) {
        const Ctx c = LC(); pg8::Gemm g{c.hb(), c.wb() + WB_1IN, MTOK, NFFIN, DM}; pg8::StaticOrder S; S.init(MTOK, NFFIN, G, bx);
#if PROBE_FFNIN == 3
        EpiNull E{(float*)c.ymix()};
        pg8::gemm_phase<EpiNull, pg8::StaticOrder, false>(c.lds, g, S, E, nullptr);
#else
        EpiSwiGLU E{c.act(), c.ssp(), (LAS float*)(c.lds + RS_LDS_OFF)};
        pg8::gemm_phase<EpiSwiGLU, pg8::StaticOrder, false>(c.lds, g, S, E, nullptr);
#endif
    }
#endif
    if (KIND(2) && IN(pb + 1)) {
        const Ctx c = LC(); pg8::Gemm g{c.hb(), c.wb() + WB_1IN, MTOK, NFFIN, DM}; pg8::StaticOrder S; S.init(MTOK, NFFIN, G, bx);
        EpiSwiGLU E{c.act(), c.ssp(), (LAS float*)(c.lds + RS_LDS_OFF)};
        pg8::gemm_phase<EpiSwiGLU, pg8::StaticOrder, false>(c.lds, g, S, E, nullptr);
    }
    SEAM(pb + 1);
    if (KIND(3) && IN(pb + 2)) {
        const Ctx c = LC(); pg8::Gemm g{c.act(), c.wb() + WB_1OUT, MTOK, DM, DFF}; pg8::StaticOrder S; S.init(MTOK, DM, G, bx);
#ifdef PROBE_RES
        { EpiResid E0{layer == 0 ? c.x() : c.h(), (float*)c.ymix(), c.hb(), c.ssp(), nullptr, 1}; pg8::gemm_phase<EpiResid, pg8::StaticOrder, false>(c.lds, g, S, E0, nullptr); }
#endif
        EpiResid E{layer == 0 ? c.x() : c.h(), c.h(), c.hb(), c.ssp(), nullptr, 0};
        pg8::gemm_phase<EpiResid, pg8::StaticOrder, false>(c.lds, g, S, E, nullptr);
    }
    SEAM(pb + 2);
    if (KIND(4) && IN(pb + 3)) for (int rep = 0; rep < PROBE_D1; ++rep) {
        const Ctx c = LC(); pg8::Gemm g{c.hb(), c.wb() + WB_MIXB, MTOK, NMIXB, DM}; pg8::StaticOrder S; S.init(MTOK, NMIXB, G, bx);
        EpiMixB E{c.ssp(), c.ymix(), c.kbuf(), c.vbuf(), c.qi(), c.ki(), c.misc(), c.ropeA(), c.ropeI(), (LAS float*)(c.lds + RS_LDS_OFF)};
        pg8::gemm_phase<EpiMixB, pg8::StaticOrder, false>(c.lds, g, S, E, nullptr);
    }
    SEAM(pb + 3);
    if (KIND(6) && IN(pb + 4)) for (int rep = 0; rep < PROBE_SEL; ++rep) phase_select(LC());
    SEAM(pb + 4);
    if (KIND(7) && IN(pb + 5)) { if (PROBE_ATTN) phase_attn(LC(), 1); phase_attn(LC(), 0); }
    SEAM(pb + 5);
    if (KIND(5) && IN(pb + 6)) for (int rep = 0; rep < PROBE_S0; ++rep) {
        const Ctx c = LC(); pg8::Gemm g{c.hb(), c.wb() + WB_MIXA, MTOK, NMIXA, DM}; pg8::StaticOrder S; S.init(MTOK, NMIXA, G, bx);
        EpiMixA E{c.ssp(), c.ymix(), c.xbc(), (LAS float*)(c.lds + RS_LDS_OFF)};
        pg8::gemm_phase<EpiMixA, pg8::StaticOrder, false>(c.lds, g, S, E, nullptr);
    }
    SEAM(pb + 6);
    if (KIND(8) && IN(pb + 7)) for (int rep = 0; rep < PROBE_S1; ++rep) phase_ssd_states(LC(), LP(7, 4 * XBCW), LP(8, XBCW), LP(9, 16), LP(10, 16));
    SEAM(pb + 7);
    if (KIND(10) && IN(pb + 8)) { if (PROBE_S3) phase_ssd_out(LC(), LP(7, 4 * XBCW), LP(8, XBCW), LP(9, 16), LP(10, 16), LP(11, 16), 1); phase_ssd_out(LC(), LP(7, 4 * XBCW), LP(8, XBCW), LP(9, 16), LP(10, 16), LP(11, 16), 0); }
    SEAM(pb + 8);
    if (KIND(9) && IN(pb + 9)) {
        const Ctx c = LC(); pg8::Gemm g{c.ymix(), c.wb() + WB_MO, MTOK, DM, 2048}; pg8::StaticOrder S; S.init(MTOK, DM, G, bx);
        EpiResidKS E{c.h(), c.h(), c.hb(), c.ssp(), c.ssq(), 0};
        pg8::gemm_phase<EpiResidKS, pg8::StaticOrder, false>(c.lds, g, S, E, nullptr);
    }
    SEAM(pb + 9);
    if (KIND(2) && IN(pb + 10)) {
        const Ctx c = LC(); pg8::Gemm g{c.hb(), c.wb() + WB_2IN, MTOK, NFFIN, DM}; pg8::StaticOrder S; S.init(MTOK, NFFIN, G, bx);
        EpiSwiGLU E{c.act(), c.ssp(), (LAS float*)(c.lds + RS_LDS_OFF)};
        pg8::gemm_phase<EpiSwiGLU, pg8::StaticOrder, false>(c.lds, g, S, E, nullptr);
    }
    SEAM(pb + 10);
    if (KIND(3) && IN(pb + 11)) {
        const Ctx c = LC(); pg8::Gemm g{c.act(), c.wb() + WB_2OUT, MTOK, DM, DFF}; pg8::StaticOrder S; S.init(MTOK, DM, G, bx);
#ifdef PROBE_RES
        { EpiResid E0{c.h(), (float*)c.ymix(), c.hb(), c.ssp(), nullptr, 1}; pg8::gemm_phase<EpiResid, pg8::StaticOrder, false>(c.lds, g, S, E0, nullptr); }
#endif
        EpiResid E{c.h(), c.h(), c.hb(), c.ssp(), nullptr, 0};
        pg8::gemm_phase<EpiResid, pg8::StaticOrder, false>(c.lds, g, S, E, nullptr);
    }
    SEAM(pb + 11);
}
__global__ void __launch_bounds__(NTHR, 2) mk_fwd(Args args) {
    extern __shared__ __attribute__((aligned(16))) unsigned char lds_raw[];
    Ctx c;
    c.lds = (LAS unsigned char*)lds_raw; c.tid = threadIdx.x; c.lane = c.tid & 63; c.wid = __builtin_amdgcn_readfirstlane(c.tid >> 6);
    unsigned char* ws = args.ws; c.ws = ws;
    const int lo = args.ph_lo, hi = args.ph_hi;
    const bool multi = (hi - lo) > 1;
    if (c.tid == 0) *(LAS u32x4*)(c.lds + LDS_BAR_OFF) = (u32x4){0u, 0u, 0u, 0u};
    __syncthreads();
    if (multi) (void)xcd_barrier_post((unsigned*)(ws + WS_CTL), (volatile LAS unsigned*)(c.lds + LDS_BAR_OFF));
    const Ctx& c0 = c;

    if (KIND(0) && IN(0)) { phase_pro(LC()); } SEAM(0);
#ifdef PROBE_BAR
    if (multi) for (int rep = 0; rep < PROBE_BAR; ++rep) xcd_barrier(make_bar(c0));
#endif
    layer_phases<0>(c0, lo, hi);
    layer_phases<1>(c0, lo, hi);


    if (KIND(12) && IN(N_PHASES - 1)) phase_final(LC(), argp(17));
#undef IN
#undef SEAM
}

#ifndef MK_N_LAUNCHES
#define MK_N_LAUNCHES 1
#endif
extern "C" void kernel_launch(void* const* d_in, const int* in_sizes, int n_in, void* d_out, int out_size, void* d_ws, size_t ws_size, hipStream_t stream) {
    static int grid = 0;
    if (grid == 0) {
        if (n_in != 18 || out_size != MTOK * DM || ws_size < WS_END) { fprintf(stderr, "kernel_launch: unexpected shapes (n_in %d out %d ws %zu need %zu)\n", n_in, out_size, ws_size, (size_t)WS_END); grid = -1; return; }
        int dev = 0, cus = 0, per_cu = 0;
        if (hipGetDevice(&dev) != hipSuccess || hipDeviceGetAttribute(&cus, hipDeviceAttributeMultiprocessorCount, dev) != hipSuccess) { grid = -1; return; }
        if (hipFuncSetAttribute((const void*)mk_fwd, hipFuncAttributeMaxDynamicSharedMemorySize, LDS_BYTES) != hipSuccess) { fprintf(stderr, "kernel_launch: hipFuncSetAttribute failed\n"); grid = -1; return; }
        if (hipOccupancyMaxActiveBlocksPerMultiprocessor(&per_cu, (const void*)mk_fwd, NTHR, LDS_BYTES) != hipSuccess || per_cu < 1) fprintf(stderr, "kernel_launch: occupancy query says %d\n", per_cu);
        (void)hipGetLastError();
        grid = cus;
    }
    if (grid < 0) return;
    (void)hipMemsetAsync((char*)d_ws + WS_CTL, 0, 64 * 1024, stream);
    Args a{};
    for (int i = 0; i < 18; ++i) a.in[i] = (const float*)d_in[i];
    a.out = (float*)d_out; a.ws = (unsigned char*)d_ws;
    for (int f = 0; f < 16; ++f) a.invf[f] = (float)pow(500000.0, -(double)(2 * f) / 32.0);
    for (int f = 0; f < 8; ++f) a.invf[16 + f] = (float)pow(500000.0, -(double)(2 * f) / 16.0);
    if (MK_N_LAUNCHES == 1) {
        a.ph_lo = 0; a.ph_hi = N_PHASES;
        hipLaunchKernelGGL(mk_fwd, dim3(grid), dim3(NTHR), LDS_BYTES, stream, a);
    } else {
        for (int p = 0; p < N_PHASES; ++p) { a.ph_lo = p; a.ph_hi = p + 1; hipLaunchKernelGGL(mk_fwd, dim3(grid), dim3(NTHR), LDS_BYTES, stream, a); }
    }
}
```

```cpp
#include <hip/hip_runtime.h>
#include <cstdio>
#include <cstdint>
#include <cmath>

#define DI __device__ __forceinline__
#define LAS __attribute__((address_space(3)))
typedef unsigned short bf16_t;
typedef short bf16x8 __attribute__((ext_vector_type(8)));
typedef short s16x4 __attribute__((ext_vector_type(4)));
typedef float f32x2 __attribute__((ext_vector_type(2)));
typedef float f32x4 __attribute__((ext_vector_type(4)));
typedef float f32x16 __attribute__((ext_vector_type(16)));
typedef unsigned u32x2 __attribute__((ext_vector_type(2)));
typedef unsigned u32x4 __attribute__((ext_vector_type(4)));
typedef __bf16 bf2_t __attribute__((ext_vector_type(2)));

DI unsigned pk2(float a, float b) { bf2_t v = __builtin_convertvector((f32x2){a, b}, bf2_t); return __builtin_bit_cast(unsigned, v); }
DI bf16_t f2bf(float a) { return (bf16_t)(pk2(a, 0.f) & 0xffffu); }
DI float bf2f(bf16_t v) { return __uint_as_float(((unsigned)v) << 16); }
DI float bflo(unsigned w) { return __uint_as_float(w << 16); }
DI float bfhi(unsigned w) { return __uint_as_float(w & 0xffff0000u); }
DI bf16x8 pack8(f32x4 a, f32x4 b) { u32x4 w = {pk2(a[0], a[1]), pk2(a[2], a[3]), pk2(b[0], b[1]), pk2(b[2], b[3])}; return __builtin_bit_cast(bf16x8, w); }
DI float silu_f(float x) { return x * __builtin_amdgcn_rcpf(1.0f + __builtin_amdgcn_exp2f(-1.4426950408889634f * x)); }
DI int crow(int r, int hi) { return (r & 3) + 8 * (r >> 2) + 4 * hi; }
#define MFMA32(a, b, c) __builtin_amdgcn_mfma_f32_32x32x16_bf16((a), (b), (c), 0, 0, 0)

constexpr int NB = 4, SEQ = 4096, MTOK = NB * SEQ, DM = 1024, DFF = 2816, NFFIN = 2 * DFF;
constexpr int NMIXB = 3840, NMIXA = 2560, DINPROJ = 6232, XBCW = 1536;
constexpr int NTHR = 512;
constexpr float EPS = 1e-6f;
constexpr int LDS_BYTES = 147456;
constexpr int LDS_BAR_OFF = LDS_BYTES - 16;

constexpr size_t KiB = 1024, MiB = 1024 * 1024;
constexpr size_t WS_CTL = 0;
constexpr size_t WS_SSP = 64 * KiB;
constexpr size_t WS_ROPEA = WS_SSP + 1 * MiB;
constexpr size_t WS_ROPEI = WS_ROPEA + 2 * MiB;
constexpr size_t WS_SSQ = WS_ROPEI + 1 * MiB;
constexpr size_t WS_CDEC = WS_SSQ + 1 * MiB;
constexpr size_t WS_WB = WS_CDEC + 64 * KiB;
constexpr size_t WS_HB = WS_WB + 50 * MiB;
constexpr size_t WS_YMIX = WS_HB + 32 * MiB;
constexpr size_t WS_MISC = WS_YMIX + 64 * MiB;
constexpr size_t WS_R = WS_MISC + 8 * MiB;
constexpr size_t WS_END = WS_R + 90 * MiB;
constexpr size_t R_K = 0, R_V = 32 * MiB, R_QI = 64 * MiB, R_KI = 80 * MiB, R_MASK = 82 * MiB;
constexpr size_t R_XBC = 0, R_STATES = 48 * MiB;
constexpr size_t R_ACT = 0;
constexpr size_t WB_1IN = 0, WB_1OUT = WB_1IN + (size_t)NFFIN * DM, WB_MIXB = WB_1OUT + (size_t)DM * DFF, WB_MIXA = WB_MIXB + (size_t)NMIXB * DM,
                 WB_MO = WB_MIXA + (size_t)NMIXA * DM, WB_2IN = WB_MO + (size_t)DM * 2048, WB_2OUT = WB_2IN + (size_t)NFFIN * DM, WB_END = WB_2OUT + (size_t)DM * DFF;
static_assert(WB_END * 2 <= 50 * MiB, "weights");

struct Args { const float* in[18]; float* out; unsigned char* ws; float invf[24]; int ph_lo, ph_hi; };

typedef const __attribute__((address_space(4))) unsigned char* kargp_t;
DI kargp_t karg_base() { kargp_t ka = (kargp_t)__builtin_amdgcn_kernarg_segment_ptr(); asm volatile("" : "+s"(ka)); return ka; }
#define GLOBAL_AS __attribute__((address_space(1)))
template <class T> DI T* as_global(T* p) { return (T*)(GLOBAL_AS T*)p; }
DI const float* argp(int i) { return *(const float* const __attribute__((address_space(4)))*)(karg_base() + 8 * i); }
struct Ctx {
    LAS unsigned char* lds; int tid, lane, wid; unsigned char* ws;
    DI const float* x() const { return argp(0); }
    DI const int* pos() const { return (const int*)argp(1); }
    DI float* h() const { return (float*)argp(18); }
    DI float* ssp() const { return (float*)(ws + WS_SSP); }
    DI f32x2* ropeA() const { return (f32x2*)(ws + WS_ROPEA); }
    DI f32x2* ropeI() const { return (f32x2*)(ws + WS_ROPEI); }
    DI float* ssq() const { return (float*)(ws + WS_SSQ); }
    DI float* cdec() const { return (float*)(ws + WS_CDEC); }
    DI bf16_t* wb() const { return (bf16_t*)(ws + WS_WB); }
    DI bf16_t* hb() const { return (bf16_t*)(ws + WS_HB); }
    DI bf16_t* ymix() const { return (bf16_t*)(ws + WS_YMIX); }
    DI float* misc() const { return (float*)(ws + WS_MISC); }
    DI bf16_t* kbuf() const { return (bf16_t*)(ws + WS_R + R_K); }
    DI bf16_t* vbuf() const { return (bf16_t*)(ws + WS_R + R_V); }
    DI bf16_t* qi() const { return (bf16_t*)(ws + WS_R + R_QI); }
    DI bf16_t* ki() const { return (bf16_t*)(ws + WS_R + R_KI); }
    DI unsigned* mask() const { return (unsigned*)(ws + WS_R + R_MASK); }
    DI bf16_t* xbc() const { return (bf16_t*)(ws + WS_R + R_XBC); }
    DI float* states() const { return (float*)(ws + WS_R + R_STATES); }
    DI bf16_t* act() const { return (bf16_t*)(ws + WS_R + R_ACT); }
};

DI float row_rstd(const float* ssp, int row) {
    const f32x4* p = (const f32x4*)(ssp + (size_t)row * 16);
    const f32x4 a = p[0], b = p[1], c = p[2], d = p[3];
    const float s = ((a[0] + a[1]) + (a[2] + a[3])) + ((b[0] + b[1]) + (b[2] + b[3])) + ((c[0] + c[1]) + (c[2] + c[3])) + ((d[0] + d[1]) + (d[2] + d[3]));
    return rsqrtf(s * (1.0f / 1024.0f) + EPS);
}
namespace pg8 {
#define PG8_LAS __attribute__((address_space(3)))
typedef unsigned short bf16_t;
typedef short bf16x8 __attribute__((ext_vector_type(8)));
typedef float f32x4 __attribute__((ext_vector_type(4)));
typedef unsigned u32x4 __attribute__((ext_vector_type(4)));
constexpr int BM = 256, BK = 64, HALF = 128, HTB = HALF * BK * 2  , STAGE_BYTES = 8 * HTB, NXCD = 8, WGM = 8;

__host__ __device__ __forceinline__ int lds_byte(int r, int c) { const int st = (r >> 4) * 2 + (c >> 5), rr = r & 15, cc = c & 31, ob = rr * 64 + cc * 2; return st * 1024 + (ob ^ (((ob >> 9) & 1) << 5)); }
__host__ __device__ __forceinline__ void stage_rc(int b, int& R, int& C) { const int st = b / 1024, sb = b % 1024, swz = sb ^ (((sb >> 9) & 1) << 5); R = (st >> 1) * 16 + swz / 64; C = (st & 1) * 32 + (swz % 64) / 2; }
__host__ __device__ __forceinline__ int perm32(int rho) { const int n = rho >> 4, i = rho & 15; return 8 * (i >> 2) + 4 * n + (i & 3); }

struct Unit { int pm, pn; };
struct Gemm { const bf16_t* A; const bf16_t* Bt; int M, N, K; };

struct StaticOrder {
    int nM, nN, nwg, G, c;
    __host__ __device__ void init(int M, int N, int G_, int c_) { nM = M / BM; nN = N / BM; nwg = nM * nN; G = G_; c = c_; }
    __host__ __device__ bool next(int i, Unit& u) const {
        const long L = (long)i * G + c; if (L >= nwg) return false;
        int wgid = (int)L; { const int q = nwg / NXCD, r = nwg % NXCD, xcd = wgid % NXCD, off = wgid / NXCD; wgid = (xcd < r ? xcd * (q + 1) : r * (q + 1) + (xcd - r) * q) + off; }
        const int nig = WGM * nN, gid = wgid / nig, fm = gid * WGM, gsz = (nM - fm) < WGM ? (nM - fm) : WGM;
        u.pm = fm + ((wgid % nig) % gsz); u.pn = (wgid % nig) / gsz; return true;
    }
    __device__ __forceinline__ void a_ready(const Unit&) const {}
    __device__ __forceinline__ void done(const Unit&) const {}
};
template <class Epi, class Sched, bool STAMP = false>
__device__ __forceinline__ void gemm_phase(PG8_LAS unsigned char* lds, const Gemm g, const Sched& S, const Epi& E, unsigned long long* stamps) {
    int tid_ = threadIdx.x; asm volatile("" : "+v"(tid_));
    const int tid = tid_, wid = __builtin_amdgcn_readfirstlane(tid >> 6), lane = tid & 63, wr = wid >> 2, wc = wid & 3, fr = lane & 15, fq = lane >> 4;
    const int K = g.K, nt = K / BK;
    int ts_lo = 0, ts_hi = 0, nts = 0; const unsigned long long rt_entry = STAMP ? (unsigned long long)wall_clock64() : 0ull;
#define PG8_STAMP() do { if (STAMP && wid == 0 && nts < 64) { const unsigned long long _c = (unsigned long long)clock64(); \
        ts_lo = (lane == nts) ? (int)(unsigned)_c : ts_lo; ts_hi = (lane == nts) ? (int)(unsigned)(_c >> 32) : ts_hi; ++nts; } } while (0)
    PG8_STAMP();
    unsigned voffA[2], voffB[2];
#pragma unroll
    for (int i = 0; i < 2; ++i) { int R, C; stage_rc(tid * 16 + i * 8192, R, C); const int Rb = Epi::PERM ? ((R & ~31) + perm32(R & 31)) : R;
        voffA[i] = (unsigned)(R * K + C) * 2u; voffB[i] = (unsigned)(Rb * K + C) * 2u; }
    const size_t kstep = (size_t)(BK * 2);
    const size_t hstep = (size_t)HALF * K * 2;
    const size_t tstep = 2 * hstep;
    const unsigned ldsw = (unsigned)wid * 1024u;
    const int aoff = lds_byte(wr * 64 + fr, fq * 8), boff = lds_byte(wc * 32 + fr, fq * 8);
#define PG8_SA(b, h) (((b) * 2 + (h)) * HTB)
#define PG8_SB(b, h) ((4 + (b) * 2 + (h)) * HTB)
#define PG8_STAGE(bufoff, gbase, voff) do { _Pragma("unroll") for (int _i = 0; _i < 2; ++_i) \
        __builtin_amdgcn_global_load_lds((const unsigned*)((const char*)(gbase) + (voff)[_i]), (PG8_LAS unsigned*)(lds + (bufoff) + ldsw + _i * 8192), 16, 0, 0); } while (0)
#define PG8_LDA(dst, b, h) do { _Pragma("unroll") for (int m = 0; m < 4; ++m) _Pragma("unroll") for (int k = 0; k < 2; ++k) dst[m][k] = *(const PG8_LAS bf16x8*)(lds + PG8_SA(b, h) + aoff + m * 2048 + k * 1024); } while (0)
#define PG8_LDB(dst, b, h) do { _Pragma("unroll") for (int n = 0; n < 2; ++n) _Pragma("unroll") for (int k = 0; k < 2; ++k) dst[n][k] = *(const PG8_LAS bf16x8*)(lds + PG8_SB(b, h) + boff + n * 2048 + k * 1024); } while (0)
#define PG8_MMA(ai, bj, At, Bt) do { __builtin_amdgcn_s_setprio(1); _Pragma("unroll") for (int m = 0; m < 4; ++m) _Pragma("unroll") for (int n = 0; n < 2; ++n) _Pragma("unroll") for (int k = 0; k < 2; ++k) \
        acc[ai][bj][m][n] = __builtin_amdgcn_mfma_f32_16x16x32_bf16(Bt[n][k], At[m][k], acc[ai][bj][m][n], 0, 0, 0); __builtin_amdgcn_s_setprio(0); } while (0)
#define PG8_WAIT_V(n) asm volatile("s_waitcnt vmcnt(" #n ")" ::: "memory")
#define PG8_WAIT_L(n) asm volatile("s_waitcnt lgkmcnt(" #n ")" ::: "memory")
#define PG8_BAR __builtin_amdgcn_s_barrier()
#define PG8_SCHED __builtin_amdgcn_sched_barrier(0)
    Unit cur, nxt; int ui = 0;
    if (!S.next(0, cur)) return;
    f32x4 acc[2][2][4][2];
#pragma unroll
    for (int a = 0; a < 2; ++a)
#pragma unroll
        for (int b = 0; b < 2; ++b)
#pragma unroll
            for (int m = 0; m < 4; ++m)
#pragma unroll
                for (int n = 0; n < 2; ++n) acc[a][b][m][n] = (f32x4){0.f, 0.f, 0.f, 0.f};
    bf16x8 At[4][2], B0[2][2], B1[2][2];
    const char* cA = (const char*)g.A + (size_t)cur.pm * tstep; const char* cB = (const char*)g.Bt + (size_t)cur.pn * tstep;
    S.a_ready(cur);
    if constexpr (Epi::PREP) E.prep(cur, 0, tid);
    PG8_STAGE(PG8_SB(0, 0), cB, voffB); PG8_STAGE(PG8_SA(0, 0), cA, voffA); PG8_STAGE(PG8_SB(0, 1), cB + hstep, voffB); PG8_STAGE(PG8_SA(0, 1), cA + hstep, voffA);
    if (wr == 1) PG8_BAR;
    PG8_WAIT_V(4); PG8_BAR;
    PG8_STAGE(PG8_SB(1, 0), cB + kstep, voffB); PG8_STAGE(PG8_SA(1, 0), cA + kstep, voffA); PG8_STAGE(PG8_SB(1, 1), cB + hstep + kstep, voffB);
    PG8_WAIT_V(6); PG8_BAR;
    PG8_STAMP();
    for (;;) {
        const bool has_next = S.next(ui + 1, nxt);
        const char* nA = has_next ? (const char*)g.A + (size_t)nxt.pm * tstep : cA; const char* nB = has_next ? (const char*)g.Bt + (size_t)nxt.pn * tstep : cB;
        for (int t = 0; t < nt; t += 2) {
            if constexpr (Epi::KSCALE) { if (t == 8 || t == 16) E.kscale(acc, cur, t, wr, fr); }
            const bool last = (t == nt - 2);
            const char* a1 = cA + (size_t)(t + 1) * kstep;
            const char* a2 = last ? nA : cA + (size_t)(t + 2) * kstep; const char* b2 = last ? nB : cB + (size_t)(t + 2) * kstep;
            const char* a3 = a2 + kstep; const char* b3 = b2 + kstep;
            if (last && has_next) { S.a_ready(nxt); if constexpr (Epi::PREP) E.prep(nxt, (ui + 1) & 1, tid); }
            PG8_LDB(B0, 0, 0); PG8_SCHED; PG8_LDA(At, 0, 0); PG8_STAGE(PG8_SA(1, 1), a1 + hstep, voffA);
            PG8_WAIT_L(8); PG8_BAR; PG8_WAIT_L(0); PG8_MMA(0, 0, At, B0); PG8_BAR; PG8_SCHED;
            PG8_LDB(B1, 0, 1); PG8_STAGE(PG8_SB(0, 0), b2, voffB);
            PG8_BAR; PG8_WAIT_L(0); PG8_MMA(0, 1, At, B1); PG8_BAR;
            PG8_LDA(At, 0, 1); PG8_STAGE(PG8_SA(0, 0), a2, voffA);
            PG8_BAR; PG8_WAIT_L(0); PG8_MMA(1, 0, At, B0); PG8_BAR; PG8_SCHED;
            PG8_STAGE(PG8_SB(0, 1), b2 + hstep, voffB);
            PG8_WAIT_V(6); PG8_BAR; PG8_MMA(1, 1, At, B1); PG8_BAR;
            PG8_LDB(B0, 1, 0); PG8_SCHED; PG8_LDA(At, 1, 0); PG8_STAGE(PG8_SA(0, 1), a2 + hstep, voffA);
            PG8_WAIT_L(8); PG8_BAR; PG8_WAIT_L(0); PG8_MMA(0, 0, At, B0); PG8_BAR; PG8_SCHED;
            PG8_LDB(B1, 1, 1); PG8_STAGE(PG8_SB(1, 0), b3, voffB);
            PG8_BAR; PG8_WAIT_L(0); PG8_MMA(0, 1, At, B1); PG8_BAR;
            PG8_LDA(At, 1, 1); PG8_STAGE(PG8_SA(1, 0), a3, voffA);
            PG8_BAR; PG8_WAIT_L(0); PG8_MMA(1, 0, At, B0); PG8_BAR; PG8_SCHED;
            PG8_STAGE(PG8_SB(1, 1), b3 + hstep, voffB);
            PG8_WAIT_V(6); PG8_BAR; PG8_MMA(1, 1, At, B1); PG8_BAR;
        }
        PG8_STAMP();
        if constexpr (!Epi::AFTER_DRAIN) { if constexpr (Epi::PREP) E(acc, cur, wr, wc, fr, fq, ui & 1); else E(acc, cur, wr, wc, fr, fq); S.done(cur); }
        PG8_STAMP();
        if (!has_next) break;
#pragma unroll
        for (int a = 0; a < 2; ++a)
#pragma unroll
            for (int b = 0; b < 2; ++b)
#pragma unroll
                for (int m = 0; m < 4; ++m)
#pragma unroll
                    for (int n = 0; n < 2; ++n) acc[a][b][m][n] = (f32x4){0.f, 0.f, 0.f, 0.f};
        cur = nxt; cA = nA; cB = nB; ++ui;
    }
    PG8_WAIT_V(0);
    if (wr == 0) PG8_BAR;
    PG8_BAR;
    if constexpr (Epi::AFTER_DRAIN) { E.fused(acc, cur, wr, wc, fr, fq, lds, wid, lane); S.done(cur); }
    PG8_STAMP();
    if (STAMP && wid == 0) { stamps[lane] = lane < nts ? (((unsigned long long)(unsigned)ts_hi << 32) | (unsigned)ts_lo) : 0ull;
        if (lane == 62) stamps[62] = rt_entry; if (lane == 63) stamps[63] = (unsigned long long)wall_clock64(); }
#undef PG8_STAMP
#undef PG8_SA
#undef PG8_SB
#undef PG8_STAGE
#undef PG8_LDA
#undef PG8_LDB
#undef PG8_MMA
#undef PG8_WAIT_V
#undef PG8_WAIT_L
#undef PG8_BAR
#undef PG8_SCHED
}
}
#define XB_TMO      128
#define XB_XCNT(j)  (256  + 64 * (j))
#define XB_XSUB(j)  (1280 + 64 * (j))
#define XB_XGEN(j)  (2304 + 64 * (j))
#define XB_TOP      3328
#define XB_TOPGEN   3392
#define XCD_BAR_WORDS 3456
#define XB_SPIN_CAP (1u << 18)
#define LAS __attribute__((address_space(3)))

__device__ __forceinline__ unsigned xb_ld(unsigned* p)              { return __hip_atomic_load(p, __ATOMIC_RELAXED, __HIP_MEMORY_SCOPE_AGENT); }
__device__ __forceinline__ unsigned xb_add(unsigned* p, unsigned v) { return __hip_atomic_fetch_add(p, v, __ATOMIC_RELAXED, __HIP_MEMORY_SCOPE_AGENT); }
__device__ __forceinline__ unsigned xb_xcc_id() { return (unsigned)__builtin_amdgcn_s_getreg((3 << 11) | 20) & 0xFu; }
#define XB_SPIN(cond, bar) do { unsigned _sp = 0; while (cond) { __builtin_amdgcn_s_sleep(1); \
    if ((++_sp & 255u) == 0u) { if (xb_ld(&(bar)[XB_TMO])) break; if (_sp > XB_SPIN_CAP) { atomicAdd(&(bar)[XB_TMO], 1u); break; } } } } while (0)

struct XcdBarrier {
    unsigned* bar; unsigned x;
    volatile LAS unsigned* st;
};

__device__ __forceinline__ XcdBarrier xcd_barrier_post(unsigned* bar, volatile LAS unsigned* st) {
    XcdBarrier b; b.bar = bar; b.x = xb_xcc_id(); b.st = st;
    if (threadIdx.x == 0) (void)xb_add(&bar[XB_XCNT(b.x)], 1u);
    return b;
}
__device__ __forceinline__ void xcd_barrier_complete(unsigned* bar, unsigned x, unsigned& nloc, unsigned& nx) {
    const unsigned G = gridDim.x * gridDim.y * gridDim.z;
    unsigned sum, cnt, mine, sp = 0u;
    for (;;) {
        sum = 0u; cnt = 0u; mine = 0u;
#pragma unroll
        for (unsigned j = 0; j < 16; ++j) { const unsigned c = xb_ld(&bar[XB_XCNT(j)]); sum += c; cnt += (c > 0u) ? 1u : 0u; mine = (j == x) ? c : mine; }
        if (sum == G) break;
        __builtin_amdgcn_s_sleep(1);
        if ((++sp & 255u) == 0u) { if (xb_ld(&bar[XB_TMO])) break; if (sp > XB_SPIN_CAP) { atomicAdd(&bar[XB_TMO], 1u); break; } }
    }
    nloc = mine > 0u ? mine : 1u; nx = cnt > 0u ? cnt : 1u;
}

__device__ __forceinline__ void xcd_barrier(const XcdBarrier& b) {
    asm volatile("s_waitcnt vmcnt(0)" ::: "memory");
    __syncthreads();
    if (threadIdx.x == 0) {
        unsigned* bar = b.bar;
        __builtin_amdgcn_s_waitcnt(0);
        unsigned nloc = b.st[0], nx = b.st[1];
        if (nloc == 0u) { xcd_barrier_complete(bar, b.x, nloc, nx); b.st[0] = nloc; b.st[1] = nx; }
        const unsigned old = xb_add(&bar[XB_XSUB(b.x)], 1u);
        const unsigned gen = old / nloc;
        if (old + 1u == (gen + 1u) * nloc) {
            __builtin_amdgcn_fence(__ATOMIC_RELEASE, "agent");
            asm volatile("s_waitcnt vmcnt(0)" ::: "memory");
            const unsigned og = xb_add(&bar[XB_TOP], 1u);
            const unsigned tg = og / nx;
            if (og + 1u == (tg + 1u) * nx) xb_add(&bar[XB_TOPGEN], 1u);
            else XB_SPIN(xb_ld(&bar[XB_TOPGEN]) == tg, bar);
            __builtin_amdgcn_fence(__ATOMIC_ACQUIRE, "agent");
            xb_add(&bar[XB_XGEN(b.x)], 1u);
            asm volatile("s_waitcnt vmcnt(0)" ::: "memory");
        } else {
            XB_SPIN(xb_ld(&bar[XB_XGEN(b.x)]) == gen, bar);
            __builtin_amdgcn_fence(__ATOMIC_ACQUIRE, "agent");
            asm volatile("s_waitcnt vmcnt(0)" ::: "memory");
        }
    }
    __syncthreads();
}

constexpr int RS_LDS_OFF = 131072;
DI void prep_rstd(const float* ssp, LAS float* tab, int pm, int par, int tid) {
    const int row = tid >> 1, hf = tid & 1;
    const f32x4* p = (const f32x4*)(ssp + (size_t)(pm * 256 + row) * 16 + hf * 8);
    const f32x4 a = p[0], b = p[1];
    float s = ((a[0] + a[1]) + (a[2] + a[3])) + ((b[0] + b[1]) + (b[2] + b[3]));
    s += __shfl_xor(s, 1);
    if (hf == 0) tab[par * 256 + row] = rsqrtf(s * (1.0f / 1024.0f) + EPS);
}
struct EpiSwiGLU {
    static constexpr bool PERM = true, AFTER_DRAIN = false, KSCALE = false, PREP = true;
    bf16_t* act; const float* ssp; LAS float* tab;
    DI void prep(const pg8::Unit& u, int par, int tid) const { prep_rstd(ssp, tab, u.pm, par, tid); }
    DI void operator()(const f32x4 (&acc)[2][2][4][2], const pg8::Unit& u, int wr, int wc, int fr, int fq, int par) const {
        const int row0 = u.pm * 256 + wr * 64 + fr, col = u.pn * 128 + wc * 32 + 8 * fq;
#pragma unroll
        for (int ai = 0; ai < 2; ++ai)
#pragma unroll
            for (int m = 0; m < 4; ++m) {
                const int row = row0 + ai * 128 + m * 16; const float rs = tab[par * 256 + ai * 128 + wr * 64 + m * 16 + fr];
                float o[8];
#pragma unroll
                for (int n = 0; n < 2; ++n)
#pragma unroll
                    for (int e = 0; e < 4; ++e) o[n * 4 + e] = silu_f(acc[ai][0][m][n][e] * rs) * (acc[ai][1][m][n][e] * rs);
                u32x4 w = {pk2(o[0], o[1]), pk2(o[2], o[3]), pk2(o[4], o[5]), pk2(o[6], o[7])};
                *(u32x4*)(act + (size_t)row * DFF + col) = w;
                asm volatile("" ::: "memory");
            }
    }
};
template <bool KS> struct EpiResidT {
    static constexpr bool PERM = false, AFTER_DRAIN = false, KSCALE = KS, PREP = false;
    const float* hin; float* hout; bf16_t* hb; float* ssp; const float* ssq; int dummy;
    DI void kscale(f32x4 (&acc)[2][2][4][2], const pg8::Unit& u, int t, int wr, int fr) const {
        int fr_ = fr; asm volatile("" : "+v"(fr_));
        const int row0 = u.pm * 256 + wr * 64 + fr_;
#pragma unroll
        for (int ai = 0; ai < 2; ++ai)
#pragma unroll
            for (int m = 0; m < 4; ++m) {
                const f32x4* sp = (const f32x4*)(ssq + (size_t)(row0 + ai * 128 + m * 16) * 16);
                const f32x4 a = sp[0], b = sp[1], c = sp[2], d = sp[3];
                const float v0 = ((a[0] + a[1]) + (a[2] + a[3]) + (b[0] + b[1]) + (b[2] + b[3])) * (1.0f / 512.0f) + EPS;
                const float v1 = ((c[0] + c[1]) + (c[2] + c[3]) + (d[0] + d[1]) + (d[2] + d[3])) * (1.0f / 512.0f) + EPS;
                const float f = (t == 8) ? rsqrtf(v0) * sqrtf(v1) : rsqrtf(v1);
#pragma unroll
                for (int bj = 0; bj < 2; ++bj)
#pragma unroll
                    for (int n = 0; n < 2; ++n) acc[ai][bj][m][n] *= f;
                asm volatile("" ::: "memory");
            }
    }
    DI void operator()(const f32x4 (&acc)[2][2][4][2], const pg8::Unit& u, int wr, int wc, int fr, int fq) const {
        const int row0 = u.pm * 256 + wr * 64 + fr, col0 = u.pn * 256 + wc * 32 + 4 * fq;
#pragma unroll
        for (int ai = 0; ai < 2; ++ai)
#pragma unroll
            for (int m = 0; m < 4; ++m) {
                const int row = row0 + ai * 128 + m * 16; float ss = 0.f;
#pragma unroll
                for (int bj = 0; bj < 2; ++bj)
#pragma unroll
                    for (int n = 0; n < 2; ++n) {
                        const size_t off = (size_t)row * DM + col0 + bj * 128 + n * 16;
                        f32x4 hv = *(const f32x4*)(hin + off); hv += acc[ai][bj][m][n];
                        *(f32x4*)(hout + off) = hv;
                        u32x2 w = {pk2(hv[0], hv[1]), pk2(hv[2], hv[3])}; if (!dummy) *(u32x2*)(hb + off) = w;
                        ss += (hv[0] * hv[0] + hv[1] * hv[1]) + (hv[2] * hv[2] + hv[3] * hv[3]);
                    }
                ss += __shfl_xor(ss, 16); ss += __shfl_xor(ss, 32);
                if (fq == 0 && !dummy) ssp[(size_t)row * 16 + u.pn * 4 + wc] = ss;
                asm volatile("" ::: "memory");
            }
    }
};
typedef EpiResidT<false> EpiResid;
typedef EpiResidT<true> EpiResidKS;
struct EpiMixA {
    static constexpr bool PERM = true, AFTER_DRAIN = false, KSCALE = false, PREP = true;
    const float* ssp; bf16_t* ymix; bf16_t* xbc; LAS float* tab;
    DI void prep(const pg8::Unit& u, int par, int tid) const { prep_rstd(ssp, tab, u.pm, par, tid); }
    DI void operator()(const f32x4 (&acc)[2][2][4][2], const pg8::Unit& u, int wr, int wc, int fr, int fq, int par) const {
        const int row0 = u.pm * 256 + wr * 64 + fr, colt = wc * 32 + 8 * fq; const int pn = u.pn;
        bf16_t* dst; int ld;
        if (pn < 4) { dst = ymix + pn * 256; ld = 2048; } else { dst = xbc + (pn - 4) * 256; ld = XBCW; }
#pragma unroll
        for (int ai = 0; ai < 2; ++ai)
#pragma unroll
            for (int m = 0; m < 4; ++m) {
                const int row = row0 + ai * 128 + m * 16; const float rs = tab[par * 256 + ai * 128 + wr * 64 + m * 16 + fr];
#pragma unroll
                for (int bj = 0; bj < 2; ++bj) {
                    const f32x4 a = acc[ai][bj][m][0] * rs, b = acc[ai][bj][m][1] * rs;
                    u32x4 w = {pk2(a[0], a[1]), pk2(a[2], a[3]), pk2(b[0], b[1]), pk2(b[2], b[3])};
                    *(u32x4*)(dst + (size_t)row * ld + bj * 128 + colt) = w;
                }
                asm volatile("" ::: "memory");
            }
    }
};
DI u32x4 pk8(const float (&v)[8]) { u32x4 w = {pk2(v[0], v[1]), pk2(v[2], v[3]), pk2(v[4], v[5]), pk2(v[6], v[7])}; return w; }
struct EpiMixB {
    static constexpr bool PERM = true, AFTER_DRAIN = false, KSCALE = false, PREP = true;
    const float* ssp; bf16_t* ymix; bf16_t* kbuf; bf16_t* vbuf; bf16_t* qi; bf16_t* ki; float* misc; const f32x2* ropeA; const f32x2* ropeI; LAS float* tab;
    DI void prep(const pg8::Unit& u, int par, int tid) const { prep_rstd(ssp, tab, u.pm, par, tid); }
    DI void operator()(const f32x4 (&acc)[2][2][4][2], const pg8::Unit& u, int wr, int wc, int fr, int fq, int par) const {
        const int row0 = u.pm * 256 + wr * 64 + fr, pos0 = wc * 32 + 8 * fq; const int pn = u.pn;
#pragma unroll
        for (int ai = 0; ai < 2; ++ai)
#pragma unroll
            for (int m = 0; m < 4; ++m) {
                const int row = row0 + ai * 128 + m * 16; const float rs = tab[par * 256 + ai * 128 + wr * 64 + m * 16 + fr];
                float X[8], Y[8];
#pragma unroll
                for (int e = 0; e < 4; ++e) { X[e] = acc[ai][0][m][0][e] * rs; X[4 + e] = acc[ai][0][m][1][e] * rs; Y[e] = acc[ai][1][m][0][e] * rs; Y[4 + e] = acc[ai][1][m][1][e] * rs; }
                if (pn < 8) {
                    bf16_t* base = (pn < 4) ? ymix + (size_t)row * 2048 + 1024 + pn * 256 : kbuf + (size_t)row * 1024 + (pn - 4) * 256;
                    if (wc == 0) {
                        const int f0 = (8 * fq) & 15; const f32x4* cp = (const f32x4*)(ropeA + (size_t)row * 16 + f0);
                        float ox[8], oy[8];
#pragma unroll
                        for (int e2 = 0; e2 < 4; ++e2) { const f32x4 cs = cp[e2];
                            ox[2 * e2] = X[2 * e2] * cs[0] - Y[2 * e2] * cs[1]; oy[2 * e2] = Y[2 * e2] * cs[0] + X[2 * e2] * cs[1];
                            ox[2 * e2 + 1] = X[2 * e2 + 1] * cs[2] - Y[2 * e2 + 1] * cs[3]; oy[2 * e2 + 1] = Y[2 * e2 + 1] * cs[2] + X[2 * e2 + 1] * cs[3]; }
                        bf16_t* hp = base + (fq >> 1) * 128 + f0;
                        *(u32x4*)hp = pk8(ox); *(u32x4*)(hp + 16) = pk8(oy);
                    } else { *(u32x4*)(base + pos0) = pk8(X); *(u32x4*)(base + 128 + pos0) = pk8(Y); }
                } else if (pn < 12) {
                    bf16_t* base = vbuf + (size_t)row * 1024 + (pn - 8) * 256 + pos0;
                    *(u32x4*)base = pk8(X); *(u32x4*)(base + 128) = pk8(Y);
                } else if (pn < 14) {
                    bf16_t* base = qi + (size_t)row * 512 + (pn - 12) * 256;
                    if (wc == 0) {
                        const f32x4* cp = (const f32x4*)(ropeI + (size_t)row * 8); float ox[8], oy[8];
#pragma unroll
                        for (int e2 = 0; e2 < 4; ++e2) { const f32x4 cs = cp[e2];
                            ox[2 * e2] = X[2 * e2] * cs[0] - Y[2 * e2] * cs[1]; oy[2 * e2] = Y[2 * e2] * cs[0] + X[2 * e2] * cs[1];
                            ox[2 * e2 + 1] = X[2 * e2 + 1] * cs[2] - Y[2 * e2 + 1] * cs[3]; oy[2 * e2 + 1] = Y[2 * e2 + 1] * cs[2] + X[2 * e2 + 1] * cs[3]; }
                        *(u32x4*)(base + fq * 64) = pk8(ox); *(u32x4*)(base + fq * 64 + 8) = pk8(oy);
                    } else { const int q0 = pos0 - 32, hh = (q0 >= 48) ? 1 : 0, d = 16 + q0 - 48 * hh;
                        *(u32x4*)(base + hh * 64 + d) = pk8(X); *(u32x4*)(base + (2 + hh) * 64 + d) = pk8(Y); }
                } else {
                    if (pos0 == 0) {
                        const f32x4* cp = (const f32x4*)(ropeI + (size_t)row * 8); float ox[8], oy[8];
#pragma unroll
                        for (int e2 = 0; e2 < 4; ++e2) { const f32x4 cs = cp[e2];
                            ox[2 * e2] = X[2 * e2] * cs[0] - Y[2 * e2] * cs[1]; oy[2 * e2] = Y[2 * e2] * cs[0] + X[2 * e2] * cs[1];
                            ox[2 * e2 + 1] = X[2 * e2 + 1] * cs[2] - Y[2 * e2 + 1] * cs[3]; oy[2 * e2 + 1] = Y[2 * e2 + 1] * cs[2] + X[2 * e2 + 1] * cs[3]; }
                        *(u32x4*)(ki + (size_t)row * 64) = pk8(ox); *(u32x4*)(ki + (size_t)row * 64 + 8) = pk8(oy);
                    } else if (pos0 < 56) { *(u32x4*)(ki + (size_t)row * 64 + 8 + pos0) = pk8(X); }
                    else if (pos0 < 80) { float* mp = misc + (size_t)row * 32 + (pos0 - 56);
                        *(f32x4*)mp = (f32x4){X[0], X[1], X[2], X[3]}; *(f32x4*)(mp + 4) = (f32x4){X[4], X[5], X[6], X[7]}; }
                }
                asm volatile("" ::: "memory");
            }
    }
};

struct EpiStoreOnly {
    static constexpr bool PERM = true, AFTER_DRAIN = false, KSCALE = false, PREP = false;
    bf16_t* act;
    DI void operator()(const f32x4 (&acc)[2][2][4][2], const pg8::Unit& u, int wr, int wc, int fr, int fq) const {
        const int row0 = u.pm * 256 + wr * 64 + fr, col = u.pn * 128 + wc * 32 + 8 * fq;
#pragma unroll
        for (int ai = 0; ai < 2; ++ai)
#pragma unroll
            for (int m = 0; m < 4; ++m) {
                const int row = row0 + ai * 128 + m * 16;
                const f32x4 a = acc[ai][0][m][0] + acc[ai][1][m][0], b2 = acc[ai][0][m][1] + acc[ai][1][m][1];
                u32x4 w = {pk2(a[0], a[1]), pk2(a[2], a[3]), pk2(b2[0], b2[1]), pk2(b2[2], b2[3])};
                *(u32x4*)(act + (size_t)row * DFF + col) = w;
            }
    }
};
struct EpiNull {
    static constexpr bool PERM = true, AFTER_DRAIN = false, KSCALE = false, PREP = false;
    float* dst;
    DI void operator()(const f32x4 (&acc)[2][2][4][2], const pg8::Unit& u, int wr, int wc, int fr, int fq) const {
        f32x4 s = {0.f, 0.f, 0.f, 0.f};
#pragma unroll
        for (int ai = 0; ai < 2; ++ai)
#pragma unroll
            for (int bj = 0; bj < 2; ++bj)
#pragma unroll
                for (int m = 0; m < 4; ++m)
#pragma unroll
                    for (int n = 0; n < 2; ++n) s += acc[ai][bj][m][n];
        *(f32x4*)(dst + ((size_t)(u.pm * 22 + u.pn) * 512 + threadIdx.x) * 4) = s;
    }
};

DI void phase_pro(const Ctx& c_in) {
    Ctx c = c_in; { int t_ = c.tid; asm volatile("" : "+v"(t_)); c.tid = t_; c.lane = t_ & 63; }
    const int gw = blockIdx.x * 8 + c.wid, nw = gridDim.x * 8;
    const float* xin = c.x(); const int* posp = c.pos();
    for (int row = gw; row < MTOK; row += nw) {
        const f32x4* src = (const f32x4*)(xin + (size_t)row * DM); float ss = 0.f;
#pragma unroll
        for (int j = 0; j < 4; ++j) {
            const f32x4 v = src[j * 64 + c.lane];
            u32x2 w = {pk2(v[0], v[1]), pk2(v[2], v[3])}; *(u32x2*)(c.hb() + (size_t)row * DM + j * 256 + c.lane * 4) = w;
            ss += (v[0] * v[0] + v[1] * v[1]) + (v[2] * v[2] + v[3] * v[3]);
        }
#pragma unroll
        for (int o = 32; o >= 1; o >>= 1) ss += __shfl_xor(ss, o);
        if (c.lane < 16) c.ssp()[(size_t)row * 16 + c.lane] = (c.lane == 0) ? ss : 0.f;
    }
    const int gt = blockIdx.x * NTHR + c.tid, nt = gridDim.x * NTHR;
    for (int i = gt; i < MTOK * 24; i += nt) {
        const int t = i / 24, f = i % 24;
        const float ang = (float)posp[t] * *(const float __attribute__((address_space(4)))*)(karg_base() + 160 + 4 * f);
        const double rev = (double)ang * 0.15915494309189533577; const double fr = rev - __builtin_rint(rev);
        const float r = (float)fr;
        const f32x2 cs = {__builtin_amdgcn_cosf(r), __builtin_amdgcn_sinf(r)};
        if (f < 16) c.ropeA()[(size_t)t * 16 + f] = cs; else c.ropeI()[(size_t)t * 8 + (f - 16)] = cs;
    }
}

template <int MAP> DI int wmap(int n) {
    if (MAP == 0) return n;
    if (MAP == 1) { const int pn = n >> 8, bj = (n >> 7) & 1, jj = n & 127; return bj * DFF + pn * 128 + jj; }
    const int pn = n >> 8, bj = (n >> 7) & 1, pos = n & 127;
    if (pn < 8) {
        const int base = (pn < 4) ? 2576 : 3600, pp = pn & 3; int head, d;
        if (pos < 16) { head = 2 * pp; d = pos + 16 * bj; }
        else if (pos < 32) { head = 2 * pp + 1; d = (pos - 16) + 16 * bj; }
        else { head = 2 * pp + bj; d = pos; }
        return base + head * 128 + d;
    }
    if (pn < 12) return 4624 + (n - 2048);
    if (pn < 14) {
        const int hA = 4 * (pn - 12); int head, d;
        if (pos < 32) { head = hA + (pos >> 3); d = (pos & 7) + 8 * bj; }
        else { const int q = pos - 32; head = hA + 2 * bj + (q >= 48 ? 1 : 0); d = 16 + (q >= 48 ? q - 48 : q); }
        return 5648 + head * 64 + d;
    }
    if (bj == 0) {
        if (pos < 8) return 6160 + pos;
        if (pos < 56) return 6160 + 8 + pos;
        if (pos < 72) return 2560 + (pos - 56);
        if (pos < 80) return 6224 + (pos - 72);
        return -1;
    }
    return (pos < 8) ? 6168 + pos : -1;
}
template <int MAP> DI void convert_w(const Ctx& c_in, const float* W, int K, int Nsrc, bf16_t* Bt, int Nout, const float* gain, int klim, float scale) {
    Ctx c = c_in; { int t_ = c.tid; asm volatile("" : "+v"(t_)); c.tid = t_; c.lane = t_ & 63; }
    LAS float* tile = (LAS float*)c.lds;
    const int nkt = K / 64, ntiles = (Nout / 64) * nkt;
    const int n4 = (c.tid & 15) * 4, kl = c.tid >> 4;
    const int sn = c.tid >> 3, sk = (c.tid & 7) * 8;
    f32x4 r0, r1; int buf = 0;
    int t = blockIdx.x;
    if (t < ntiles) {
        const int n0 = (t / nkt) * 64, k0 = (t % nkt) * 64, src = wmap<MAP>(n0 + n4); const int srcc = src >= 0 ? src : 0;
        r0 = *(const f32x4*)(W + (size_t)(k0 + kl) * Nsrc + srcc); r1 = *(const f32x4*)(W + (size_t)(k0 + kl + 32) * Nsrc + srcc);
        if (src < 0) { r0 = (f32x4){0.f, 0.f, 0.f, 0.f}; r1 = r0; }
    }
    for (; t < ntiles; t += gridDim.x) {
        const int n0 = (t / nkt) * 64, k0 = (t % nkt) * 64;
        {
            const float g0 = ((gain != nullptr && k0 + kl < klim) ? gain[k0 + kl] : 1.f) * scale, g1 = ((gain != nullptr && k0 + kl + 32 < klim) ? gain[k0 + kl + 32] : 1.f) * scale;
            LAS float* tb = tile + buf * (64 * 65);
#pragma unroll
            for (int e = 0; e < 4; ++e) { tb[kl * 65 + n4 + e] = r0[e] * g0; tb[(kl + 32) * 65 + n4 + e] = r1[e] * g1; }
        }
        __syncthreads();
        const int t2 = t + gridDim.x;
        if (t2 < ntiles) {
            const int n02 = (t2 / nkt) * 64, k02 = (t2 % nkt) * 64, src = wmap<MAP>(n02 + n4); const int srcc = src >= 0 ? src : 0;
            r0 = *(const f32x4*)(W + (size_t)(k02 + kl) * Nsrc + srcc); r1 = *(const f32x4*)(W + (size_t)(k02 + kl + 32) * Nsrc + srcc);
            if (src < 0) { r0 = (f32x4){0.f, 0.f, 0.f, 0.f}; r1 = r0; }
        }
        {
            const LAS float* tb = tile + buf * (64 * 65);
            u32x4 w;
#pragma unroll
            for (int e = 0; e < 4; ++e) w[e] = pk2(tb[(sk + 2 * e) * 65 + sn], tb[(sk + 2 * e + 1) * 65 + sn]);
            *(u32x4*)(Bt + (size_t)(n0 + sn) * K + k0 + sk) = w;
        }
        buf ^= 1;
    }
    __syncthreads();
}


#define WRLANE(dst, sval, ln) asm volatile("s_nop 3\n\tv_writelane_b32 %0, %1, %2" : "+v"(dst) : "s"(sval), "n"(ln))
DI unsigned ord_key(float v) { const unsigned u = __float_as_uint(v); return u ^ ((u & 0x80000000u) ? 0xffffffffu : 0x80000000u); }
DI void sel_load_q(const Ctx& c, int u, int c32, int hi, bf16x8 (&af)[2][4], float (&wv)[2][4][4]) {
    const int t8 = (SEQ / 8 - 1) - (u >> 2), b = u & 3; const size_t tok0 = (size_t)b * SEQ + t8 * 8;
#pragma unroll
    for (int mt = 0; mt < 2; ++mt) {
        const size_t tq = tok0 + 4 * mt + (c32 >> 3);
#pragma unroll
        for (int ks = 0; ks < 4; ++ks) af[mt][ks] = *(const bf16x8*)(c.qi() + tq * 512 + (c32 & 7) * 64 + 16 * ks + 8 * hi);
#pragma unroll
        for (int tl = 0; tl < 4; ++tl) { const f32x4 w4 = *(const f32x4*)(c.misc() + (tok0 + 4 * mt + tl) * 32 + 16 + 4 * hi);
            wv[mt][tl][0] = w4[0]; wv[mt][tl][1] = w4[1]; wv[mt][tl][2] = w4[2]; wv[mt][tl][3] = w4[3]; }
    }
}
DI void sel_load_kgroup(const bf16_t* kbase, int kt0, int nkt, bf16x8 (&b)[4][4]) {
#pragma unroll
    for (int j = 0; j < 4; ++j) { const int kt = (kt0 + 8 * j < nkt) ? kt0 + 8 * j : nkt - 1;
#pragma unroll
        for (int ks = 0; ks < 4; ++ks) b[j][ks] = *(const bf16x8*)(kbase + (size_t)kt * 32 * 64 + 16 * ks); }
}
DI void sel_score_group(const bf16x8 (&af)[2][4], const float (&wv)[2][4][4], const bf16x8 (&b)[4][4], LAS float* sc, int kt0, int nkt, int c32, int hi) {
#pragma unroll
    for (int j = 0; j < 4; ++j) { const int kt = kt0 + 8 * j;
        if (kt < nkt) {
            const int s0 = kt * 32;
#pragma unroll
            for (int mt = 0; mt < 2; ++mt) {
                f32x16 acc = {};
#pragma unroll
                for (int ks = 0; ks < 4; ++ks) acc = MFMA32(af[mt][ks], b[j][ks], acc);
                float tot[4];
#pragma unroll
                for (int tl = 0; tl < 4; ++tl) {
                    float p = 0.f;
#pragma unroll
                    for (int jj = 0; jj < 4; ++jj) p += wv[mt][tl][jj] * fmaxf(acc[4 * tl + jj], 0.f);
                    const auto rr = __builtin_amdgcn_permlane32_swap(__float_as_uint(p), __float_as_uint(p), false, false);
                    tot[tl] = (__uint_as_float(rr[0]) + __uint_as_float(rr[1])) + 0.0f;
                }
                const int ql = 4 * mt + 2 * hi;
                sc[ql * 4096 + s0 + c32] = hi ? tot[2] : tot[0];
                sc[(ql + 1) * 4096 + s0 + c32] = hi ? tot[3] : tot[1];
            }
        } }
}
DI void sel_score_tile(const bf16x8 (&af)[2][4], const float (&wv)[2][4][4], const bf16x8 (&b)[4], LAS float* sc, int s0, int c32, int hi) {
#pragma unroll
    for (int mt = 0; mt < 2; ++mt) {
        f32x16 acc = {};
#pragma unroll
        for (int ks = 0; ks < 4; ++ks) acc = MFMA32(af[mt][ks], b[ks], acc);
        float tot[4];
#pragma unroll
        for (int tl = 0; tl < 4; ++tl) {
            float p = 0.f;
#pragma unroll
            for (int jj = 0; jj < 4; ++jj) p += wv[mt][tl][jj] * fmaxf(acc[4 * tl + jj], 0.f);
            const auto rr = __builtin_amdgcn_permlane32_swap(__float_as_uint(p), __float_as_uint(p), false, false);
            tot[tl] = (__uint_as_float(rr[0]) + __uint_as_float(rr[1])) + 0.0f;
        }
        const int ql = 4 * mt + 2 * hi;
        sc[ql * 4096 + s0 + c32] = hi ? tot[2] : tot[0];
        sc[(ql + 1) * 4096 + s0 + c32] = hi ? tot[3] : tot[1];
    }
}
DI void phase_select(const Ctx& c_in) {
    Ctx c = c_in; { int t_ = c.tid; asm volatile("" : "+v"(t_)); c.tid = t_; c.lane = t_ & 63; }
    LAS float* sc = (LAS float*)c.lds;
    const int lane = c.lane, wid = c.wid, c32 = lane & 31, hi = lane >> 5;
    bf16x8 af[2][4]; float wv[2][4][4];
    if ((int)blockIdx.x < NB * (SEQ / 8)) sel_load_q(c, blockIdx.x, c32, hi, af, wv);
    for (int u = blockIdx.x; u < NB * (SEQ / 8); u += gridDim.x) {
        const int t8 = (SEQ / 8 - 1) - (u >> 2), b = u & 3, t0 = t8 * 8;
        const int nkt = (t0 + 7) / 32 + 1;
        const bf16_t* kbase = c.ki() + ((size_t)b * SEQ + c32) * 64 + 8 * hi;
        {
            bf16x8 bcur[4], bnxt[4];
            { const int kt = (wid < nkt) ? wid : nkt - 1;
#pragma unroll
              for (int ks = 0; ks < 4; ++ks) bcur[ks] = *(const bf16x8*)(kbase + (size_t)kt * 32 * 64 + 16 * ks); }
            for (int kt = wid; kt < nkt; kt += 8) {
                { const int k2 = (kt + 8 < nkt) ? kt + 8 : nkt - 1;
#pragma unroll
                  for (int ks = 0; ks < 4; ++ks) bnxt[ks] = *(const bf16x8*)(kbase + (size_t)k2 * 32 * 64 + 16 * ks); }
                sel_score_tile(af, wv, bcur, sc, kt * 32, c32, hi);
#pragma unroll
                for (int ks = 0; ks < 4; ++ks) bcur[ks] = bnxt[ks];
            }
        }
        if (u + (int)gridDim.x < NB * (SEQ / 8)) sel_load_q(c, u + gridDim.x, c32, hi, af, wv);
        __syncthreads();
        {
            int lane_ = c.lane; asm volatile("" : "+v"(lane_)); const int lane = lane_;
            const int t = t0 + wid; unsigned mlo = 0u, mhi = 0u;
            if (t < 256) {
#pragma unroll
                for (int r = 0; r < 64; ++r) {
                    const unsigned long long bal = __ballot(r * 64 + lane <= t);
                    WRLANE(mlo, (unsigned)bal, r); WRLANE(mhi, (unsigned)(bal >> 32), r);
                    __builtin_amdgcn_sched_barrier(0);
                }
            } else {
                unsigned key[64];
                const int nreg = (t >> 6) + 1;
#pragma unroll
                for (int r = 0; r < 64; ++r) { const int s = r * 64 + lane; const float v = sc[wid * 4096 + s]; key[r] = (s <= t) ? ord_key(v) : 0u; }
#ifndef PROBE_BITS
#define PROBE_BITS 1
#endif
                unsigned T = 0u; int cge = 4096;
                for (int rep = 0; rep < PROBE_BITS; ++rep) { T = 0u;
                for (int bit = 31; bit >= 0; --bit) {
                    const unsigned cand = T | (1u << bit); int cnt = 0;
#pragma unroll
                    for (int g = 0; g < 8; ++g) {
                        if (g * 8 < nreg) {
                            { unsigned long long m0 = __ballot(key[g * 8] >= cand), m1 = __ballot(key[g * 8 + 1] >= cand), m2 = __ballot(key[g * 8 + 2] >= cand), m3 = __ballot(key[g * 8 + 3] >= cand),
                                                 m4 = __ballot(key[g * 8 + 4] >= cand), m5 = __ballot(key[g * 8 + 5] >= cand), m6 = __ballot(key[g * 8 + 6] >= cand), m7 = __ballot(key[g * 8 + 7] >= cand);
                              asm volatile("" : "+s"(m0), "+s"(m1), "+s"(m2), "+s"(m3), "+s"(m4), "+s"(m5), "+s"(m6), "+s"(m7));
                              cnt += (__popcll(m0) + __popcll(m1)) + (__popcll(m2) + __popcll(m3)) + ((__popcll(m4) + __popcll(m5)) + (__popcll(m6) + __popcll(m7))); }
                        }
                        __builtin_amdgcn_sched_barrier(0);
                    }
                    if (cnt >= 256) { T = cand; cge = cnt; if (cnt == 256) break; }
                } }
#ifndef PROBE_FINAL
#define PROBE_FINAL 1
#endif
                for (int repf = 0; repf < PROBE_FINAL; ++repf) {
                if (cge == 256) {
#pragma unroll
                    for (int g = 0; g < 8; ++g) {
                        if (g * 8 < nreg) {
#pragma unroll
                            for (int rr = 0; rr < 8; ++rr) { const unsigned long long word = __ballot(key[g * 8 + rr] >= T);
                                WRLANE(mlo, (unsigned)word, g * 8 + rr); WRLANE(mhi, (unsigned)(word >> 32), g * 8 + rr); }
                        }
                        __builtin_amdgcn_sched_barrier(0);
                    }
                } else {
                int cgt = 0;
#pragma unroll
                for (int g = 0; g < 8; ++g) {
#pragma unroll
                    for (int rr = 0; rr < 8; ++rr) cgt += __popcll(__ballot(key[g * 8 + rr] > T));
                    __builtin_amdgcn_sched_barrier(0);
                }
                int need = 256 - cgt;
#pragma unroll
                for (int r = 0; r < 64; ++r) {
                    const unsigned long long gt = __ballot(key[r] > T); unsigned long long eq = __ballot(key[r] == T), take;
                    const int ne = __popcll(eq);
                    if (ne <= need) { take = eq; need -= ne; }
                    else { take = 0ull; while (need > 0) { const unsigned long long low = eq & (0ull - eq); take |= low; eq ^= low; --need; } }
                    const unsigned long long word = gt | take;
                    WRLANE(mlo, (unsigned)word, r); WRLANE(mhi, (unsigned)(word >> 32), r);
                    __builtin_amdgcn_sched_barrier(0);
                }
                }
                }
            }
            u32x2 w = {mlo, mhi};
            *(u32x2*)(c.mask() + ((size_t)b * SEQ + t) * 128 + 2 * lane) = w;
        }
        __syncthreads();
    }
}

constexpr int VT_PITCH = 144;
constexpr int ATT_K_OFF = 0, ATT_V_OFF = 16384;
DI void phase_attn(const Ctx& c_in, const int dummy) {
    Ctx c = c_in; { int t_ = c.tid; asm volatile("" : "+v"(t_)); c.tid = t_; c.lane = t_ & 63; }
    LAS unsigned char* Kl = c.lds + ATT_K_OFF; LAS unsigned char* Vl = c.lds + ATT_V_OFF;
    const int lane = c.lane, wid = c.wid, tid = c.tid, c32 = lane & 31, hi = lane >> 5;
    constexpr float C2 = 0.08838834764831845f * 1.4426950408889634f;
    const float NEG = -__builtin_inff();
    for (int u = blockIdx.x; u < NB * 8 * 8; u += gridDim.x) {
        const int x = u & 7, hd = (u >> 3) & 7, b = u >> 6;
        for (int half = 0; half < 2; ++half) {
            const int qb = half ? 15 - x : x, P0 = qb * 256; const size_t tq = (size_t)b * SEQ + P0 + 32 * wid + c32;
            bf16_t* qptr = c.ymix() + tq * 2048 + 1024 + hd * 128;
            bf16x8 qr[8];
#pragma unroll
            for (int d0 = 0; d0 < 8; ++d0) qr[d0] = *(const bf16x8*)(qptr + 16 * d0 + 8 * hi);
            float m_run = -1e30f, l_run = 0.f; f32x16 o[4] = {};
            const int ntiles = P0 / 64 + 4, qmax = P0 + 32 * wid + 31;
            const bf16_t* kbase = c.kbuf() + (size_t)b * SEQ * 1024 + hd * 128; const bf16_t* vbase = c.vbuf() + (size_t)b * SEQ * 1024 + hd * 128;
            const unsigned* mrow = c.mask() + tq * 128;
            bf16x8 sk0, sk1, sv0, sv1;
            {
                sk0 = *(const bf16x8*)(kbase + (size_t)(tid >> 4) * 1024 + (tid & 15) * 8); sk1 = *(const bf16x8*)(kbase + (size_t)(32 + (tid >> 4)) * 1024 + (tid & 15) * 8);
                sv0 = *(const bf16x8*)(vbase + (size_t)lane * 1024 + 16 * wid); sv1 = *(const bf16x8*)(vbase + (size_t)lane * 1024 + 16 * wid + 8);
            }
            u32x2 mw = *(const u32x2*)(mrow);
            for (int j = 0; j < ntiles; ++j) {
                __syncthreads();
                {
                    const int key = tid >> 4, ch = tid & 15;
                    *(LAS bf16x8*)(Kl + key * 256 + ((ch * 16) ^ ((key & 7) << 4))) = sk0;
                    *(LAS bf16x8*)(Kl + (key + 32) * 256 + ((ch * 16) ^ ((key & 7) << 4))) = sk1;
#pragma unroll
                    for (int e = 0; e < 8; ++e) { *(LAS short*)(Vl + (16 * wid + e) * VT_PITCH + lane * 2) = sv0[e]; *(LAS short*)(Vl + (16 * wid + 8 + e) * VT_PITCH + lane * 2) = sv1[e]; }
                }
                __syncthreads();
                const u32x2 mcur = mw;
                if (j + 1 < ntiles) {
                    const size_t k0 = (size_t)(j + 1) * 64;
                    sk0 = *(const bf16x8*)(kbase + (k0 + (tid >> 4)) * 1024 + (tid & 15) * 8); sk1 = *(const bf16x8*)(kbase + (k0 + 32 + (tid >> 4)) * 1024 + (tid & 15) * 8);
                    sv0 = *(const bf16x8*)(vbase + (k0 + lane) * 1024 + 16 * wid); sv1 = *(const bf16x8*)(vbase + (k0 + lane) * 1024 + 16 * wid + 8);
                    mw = *(const u32x2*)(mrow + 2 * (j + 1));
                }
                if (j * 64 <= qmax) {
                    f32x16 p0 = {}, p1 = {};
#pragma unroll
                    for (int d0 = 0; d0 < 8; ++d0) {
                        const int ch = 2 * d0 + hi;
                        const bf16x8 a0 = *(const LAS bf16x8*)(Kl + c32 * 256 + ((ch * 16) ^ ((c32 & 7) << 4)));
                        const bf16x8 a1 = *(const LAS bf16x8*)(Kl + (c32 + 32) * 256 + ((ch * 16) ^ ((c32 & 7) << 4)));
                        p0 = MFMA32(a0, qr[d0], p0); p1 = MFMA32(a1, qr[d0], p1);
                    }
                    const unsigned w0 = mcur[0] >> (4 * hi), w1 = mcur[1] >> (4 * hi);
                    float tmax = NEG;
#pragma unroll
                    for (int r = 0; r < 16; ++r) {
                        const unsigned bit = 1u << ((r & 3) + 8 * (r >> 2));
                        p0[r] = (w0 & bit) ? p0[r] : NEG; p1[r] = (w1 & bit) ? p1[r] : NEG;
                        tmax = fmaxf(tmax, fmaxf(p0[r], p1[r]));
                    }
                    tmax = fmaxf(tmax, __shfl_xor(tmax, 32));
                    const float mn = fmaxf(m_run, tmax); const float alpha = __builtin_amdgcn_exp2f((m_run - mn) * C2); m_run = mn;
                    const float mnl = -mn * C2; float ps = 0.f;
#pragma unroll
                    for (int r = 0; r < 16; ++r) { p0[r] = __builtin_amdgcn_exp2f(fmaf(p0[r], C2, mnl)); p1[r] = __builtin_amdgcn_exp2f(fmaf(p1[r], C2, mnl)); ps += p0[r] + p1[r]; }
                    l_run = l_run * alpha + ps;
                    if (!__all(alpha == 1.0f)) {
#pragma unroll
                        for (int db = 0; db < 4; ++db)
#pragma unroll
                            for (int r = 0; r < 16; ++r) o[db][r] *= alpha;
                    }
                    bf16x8 pb[4];
                    pb[0] = pack8((f32x4){p0[0], p0[1], p0[2], p0[3]}, (f32x4){p0[4], p0[5], p0[6], p0[7]});
                    pb[1] = pack8((f32x4){p0[8], p0[9], p0[10], p0[11]}, (f32x4){p0[12], p0[13], p0[14], p0[15]});
                    pb[2] = pack8((f32x4){p1[0], p1[1], p1[2], p1[3]}, (f32x4){p1[4], p1[5], p1[6], p1[7]});
                    pb[3] = pack8((f32x4){p1[8], p1[9], p1[10], p1[11]}, (f32x4){p1[12], p1[13], p1[14], p1[15]});
#pragma unroll
                    for (int db = 0; db < 4; ++db)
#pragma unroll
                        for (int ks = 0; ks < 4; ++ks) {
                            const LAS unsigned char* vp = Vl + (32 * db + c32) * VT_PITCH + (16 * ks + 4 * hi) * 2;
                            const s16x4 lo = *(const LAS s16x4*)vp, hh = *(const LAS s16x4*)(vp + 16);
                            const bf16x8 a = {lo[0], lo[1], lo[2], lo[3], hh[0], hh[1], hh[2], hh[3]};
                            o[db] = MFMA32(a, pb[ks], o[db]);
                        }
                }
            }
            l_run += __shfl_xor(l_run, 32);
            const float rl = 1.0f / l_run;
#pragma unroll
            for (int db = 0; db < 4; ++db)
#pragma unroll
                for (int g = 0; g < 4; ++g) {
                    u32x2 w = {pk2(o[db][4 * g] * rl, o[db][4 * g + 1] * rl), pk2(o[db][4 * g + 2] * rl, o[db][4 * g + 3] * rl)};
                    *(u32x2*)((dummy ? qptr - 1024 : qptr) + 32 * db + 8 * g + 4 * hi) = w;
                }
        }
    }
}

template <int NT> DI void conv_seg(const bf16_t* xbc, size_t tok_first, int pos_first, int cidx, const float* cw, const float* cb, float (&out)[NT][8]) {
    u32x4 rows[NT + 3];
#pragma unroll
    for (int i = 0; i < NT + 3; ++i) {
        const int off = i - 3, offc = (off < -pos_first) ? -pos_first : off;
        const u32x4 v = *(const u32x4*)(xbc + (size_t)((long)tok_first + offc) * XBCW + cidx);
        const bool ok = (pos_first + off >= 0);
        rows[i] = (u32x4){ok ? v[0] : 0u, ok ? v[1] : 0u, ok ? v[2] : 0u, ok ? v[3] : 0u};
    }
    float w[4][8], bias[8];
#pragma unroll
    for (int k = 0; k < 4; ++k) { const f32x4 w0 = *(const f32x4*)(cw + k * XBCW + cidx), w1 = *(const f32x4*)(cw + k * XBCW + cidx + 4);
        w[k][0] = w0[0]; w[k][1] = w0[1]; w[k][2] = w0[2]; w[k][3] = w0[3]; w[k][4] = w1[0]; w[k][5] = w1[1]; w[k][6] = w1[2]; w[k][7] = w1[3]; }
    { const f32x4 b0 = *(const f32x4*)(cb + cidx), b1 = *(const f32x4*)(cb + cidx + 4);
      bias[0] = b0[0]; bias[1] = b0[1]; bias[2] = b0[2]; bias[3] = b0[3]; bias[4] = b1[0]; bias[5] = b1[1]; bias[6] = b1[2]; bias[7] = b1[3]; }
#pragma unroll
    for (int j = 0; j < NT; ++j)
#pragma unroll
        for (int e = 0; e < 8; ++e) {
            float a = bias[e];
#pragma unroll
            for (int k = 0; k < 4; ++k) { const unsigned wd = rows[j + k][e >> 1]; a += w[k][e] * ((e & 1) ? bfhi(wd) : bflo(wd)); }
            out[j][e] = silu_f(a);
        }
}
constexpr int SSD_PITCH = 264;
DI void ssd_dt_scan(const Ctx& c, LAS float* dtl, LAS float* acs, size_t tok0, int h, const float* dt_bias, const float* a_log) {
    if (c.tid < 256) {
        const float v = c.misc()[(tok0 + c.tid) * 32 + h] + dt_bias[h];
        const float sp = fmaxf(v, 0.f) + log1pf(__expf(-fabsf(v)));
        dtl[c.tid] = sp;
    }
    __syncthreads();
    if (c.wid == 0) {
        const float a = -__expf(a_log[h]);
        const float a0 = dtl[4 * c.lane] * a, a1 = dtl[4 * c.lane + 1] * a, a2 = dtl[4 * c.lane + 2] * a, a3 = dtl[4 * c.lane + 3] * a;
        const float s1 = a0, s2 = s1 + a1, s3 = s2 + a2, s4 = s3 + a3; float tot = s4;
#pragma unroll
        for (int off = 1; off < 64; off <<= 1) { const float n = __shfl_up(tot, off); if (c.lane >= off) tot += n; }
        const float base = tot - s4;
        acs[4 * c.lane] = base + s1; acs[4 * c.lane + 1] = base + s2; acs[4 * c.lane + 2] = base + s3; acs[4 * c.lane + 3] = base + s4;
    }
    __syncthreads();
}
DI void phase_ssd_states(const Ctx& c_in, const float* cw, const float* cb, const float* dt_bias, const float* a_log) {
    Ctx c = c_in; { int t_ = c.tid; asm volatile("" : "+v"(t_)); c.tid = t_; c.lane = t_ & 63; }
    LAS bf16_t* XT = (LAS bf16_t*)c.lds;
    LAS bf16_t* BT = (LAS bf16_t*)(c.lds + 64 * SSD_PITCH * 2);
    LAS float* dtl = (LAS float*)(c.lds + 192 * SSD_PITCH * 2); LAS float* acs = dtl + 256;
    const int lane = c.lane, wid = c.wid, tid = c.tid, c32 = lane & 31, hi = lane >> 5;
    for (int u = blockIdx.x; u < 1024; u += gridDim.x) {
        const int h = u & 15, ch = (u >> 4) & 15, b = u >> 8, g = h >> 3; const size_t tok0 = (size_t)b * SEQ + ch * 256;
        ssd_dt_scan(c, dtl, acs, tok0, h, dt_bias, a_log);
        const float alast = acs[255];
        {
            const int oct = tid & 7, l0 = (tid >> 3) * 4; float v[4][8];
            conv_seg<4>(c.xbc(), tok0 + l0, ch * 256 + l0, h * 64 + oct * 8, cw, cb, v);
            float sc[4];
#pragma unroll
            for (int j = 0; j < 4; ++j) sc[j] = dtl[l0 + j] * __expf(alast - acs[l0 + j]);
#pragma unroll
            for (int e = 0; e < 8; ++e) { u32x2 w = {pk2(v[0][e] * sc[0], v[1][e] * sc[1]), pk2(v[2][e] * sc[2], v[3][e] * sc[3])}; *(LAS u32x2*)(XT + (oct * 8 + e) * SSD_PITCH + l0) = w; }
        }
        {
            const int oct = tid & 15, l0 = (tid >> 4) * 8; float v[8][8];
            conv_seg<8>(c.xbc(), tok0 + l0, ch * 256 + l0, 1024 + g * 128 + oct * 8, cw, cb, v);
#pragma unroll
            for (int e = 0; e < 8; ++e) { u32x4 w = {pk2(v[0][e], v[1][e]), pk2(v[2][e], v[3][e]), pk2(v[4][e], v[5][e]), pk2(v[6][e], v[7][e])}; *(LAS u32x4*)(BT + (oct * 8 + e) * SSD_PITCH + l0) = w; }
        }
        __syncthreads();
        const int pb = wid >> 2, nb = wid & 3; f32x16 acc = {};
#pragma unroll
        for (int ks = 0; ks < 16; ++ks) {
            const bf16x8 a = *(const LAS bf16x8*)(XT + (32 * pb + c32) * SSD_PITCH + 16 * ks + 8 * hi);
            const bf16x8 bb = *(const LAS bf16x8*)(BT + (32 * nb + c32) * SSD_PITCH + 16 * ks + 8 * hi);
            acc = MFMA32(a, bb, acc);
        }
        float* st = c.states() + (size_t)u * 8192;
#pragma unroll
        for (int r = 0; r < 16; ++r) st[(32 * pb + crow(r, hi)) * 128 + 32 * nb + c32] = acc[r];
        if (tid == 0) c.cdec()[u] = __expf(alast);
        __syncthreads();
    }
}
DI void phase_ssd_out(const Ctx& c_in, const float* cw, const float* cb, const float* dt_bias, const float* a_log, const float* d_skip, const int dummy) {
    Ctx c = c_in; { int t_ = c.tid; asm volatile("" : "+v"(t_)); c.tid = t_; c.lane = t_ & 63; }
    LAS unsigned char* Bn = c.lds;
    LAS bf16_t* XT = (LAS bf16_t*)(c.lds + 65536);
    LAS bf16_t* Hs = (LAS bf16_t*)(c.lds + 65536 + 64 * SSD_PITCH * 2);
    LAS float* dtl = (LAS float*)(c.lds + 65536 + 64 * SSD_PITCH * 2 + 64 * 136 * 2); LAS float* acs = dtl + 256;
    const int wid = c.wid;
    for (int u = blockIdx.x; u < 1024; u += gridDim.x) {
        int tid_ = c.tid; asm volatile("" : "+v"(tid_)); const int tid = tid_, lane = tid & 63, c32 = lane & 31, hi = lane >> 5;
        const int h = u & 15, ch = (u >> 4) & 15, b = u >> 8, g = h >> 3; const size_t tok0 = (size_t)b * SEQ + ch * 256;
        ssd_dt_scan(c, dtl, acs, tok0, h, dt_bias, a_log);
        {
            const int oct = tid & 15;
#pragma unroll 1
            for (int hf = 0; hf < 2; ++hf) { const int l0 = (tid >> 4) * 8 + 4 * hf; float v[4][8];
                conv_seg<4>(c.xbc(), tok0 + l0, ch * 256 + l0, 1280 + g * 128 + oct * 8, cw, cb, v);
#pragma unroll
                for (int j = 0; j < 4; ++j) { const int l = l0 + j;
                    *(LAS bf16x8*)(Bn + l * 256 + ((oct * 16) ^ ((l & 7) << 4))) = pack8((f32x4){v[j][0], v[j][1], v[j][2], v[j][3]}, (f32x4){v[j][4], v[j][5], v[j][6], v[j][7]}); } }
        }
        {
            const int oct = tid & 7, l0 = (tid >> 3) * 4; float v[4][8];
            conv_seg<4>(c.xbc(), tok0 + l0, ch * 256 + l0, h * 64 + oct * 8, cw, cb, v);
#pragma unroll
            for (int e = 0; e < 8; ++e) { u32x2 w = {pk2(v[0][e], v[1][e]), pk2(v[2][e], v[3][e])}; *(LAS u32x2*)(XT + (oct * 8 + e) * SSD_PITCH + l0) = w; }
        }
        {
            const int p = tid >> 3, n0 = (tid & 7) * 16; f32x4 hs[4] = {};
            for (int cc = 0; cc < ch; ++cc) {
                const int u2 = ((b * 16 + cc) << 4) + h; const float* sp = c.states() + (size_t)u2 * 8192 + p * 128 + n0; const float dec = c.cdec()[u2];
#pragma unroll
                for (int q = 0; q < 4; ++q) hs[q] = hs[q] * dec + *(const f32x4*)(sp + 4 * q);
            }
            *(LAS bf16x8*)(Hs + p * 136 + n0) = pack8(hs[0], hs[1]); *(LAS bf16x8*)(Hs + p * 136 + n0 + 8) = pack8(hs[2], hs[3]);
        }
        __syncthreads();
        const int l = 32 * wid + c32; bf16x8 qr[8];
#pragma unroll
        for (int ks = 0; ks < 8; ++ks) qr[ks] = *(const LAS bf16x8*)(Bn + l * 256 + (((2 * ks + hi) * 16) ^ ((l & 7) << 4)));
        __syncthreads();
        {
            const int oct = tid & 15;
#pragma unroll 1
            for (int hf = 0; hf < 2; ++hf) { const int l0 = (tid >> 4) * 8 + 4 * hf; float v[4][8];
                conv_seg<4>(c.xbc(), tok0 + l0, ch * 256 + l0, 1024 + g * 128 + oct * 8, cw, cb, v);
#pragma unroll
                for (int j = 0; j < 4; ++j) { const int l2 = l0 + j;
                    *(LAS bf16x8*)(Bn + l2 * 256 + ((oct * 16) ^ ((l2 & 7) << 4))) = pack8((f32x4){v[j][0], v[j][1], v[j][2], v[j][3]}, (f32x4){v[j][4], v[j][5], v[j][6], v[j][7]}); } }
        }
        __syncthreads();
        const float acs_l = acs[l], dsk = d_skip[h];
        f32x16 o[2] = {};
        for (int j = 0; j <= wid; ++j) {
            f32x16 p = {};
#pragma unroll
            for (int ks = 0; ks < 8; ++ks) {
                const int row = 32 * j + c32, chn = 2 * ks + hi;
                const bf16x8 a = *(const LAS bf16x8*)(Bn + row * 256 + ((chn * 16) ^ ((row & 7) << 4)));
                p = MFMA32(a, qr[ks], p);
            }
#pragma unroll
            for (int r = 0; r < 16; ++r) {
                const int s = 32 * j + crow(r, hi);
                float v = p[r] * __expf(acs_l - acs[s]) * dtl[s];
                v = (s <= l) ? v : 0.f;
                p[r] = (s == l) ? v + dsk : v;
            }
            bf16x8 pb[2];
            pb[0] = pack8((f32x4){p[0], p[1], p[2], p[3]}, (f32x4){p[4], p[5], p[6], p[7]});
            pb[1] = pack8((f32x4){p[8], p[9], p[10], p[11]}, (f32x4){p[12], p[13], p[14], p[15]});
#pragma unroll
            for (int pk = 0; pk < 2; ++pk)
#pragma unroll
                for (int ks = 0; ks < 2; ++ks) {
                    const LAS bf16_t* xp = XT + (32 * pk + c32) * SSD_PITCH + 32 * j + 16 * ks + 4 * hi;
                    const s16x4 lo = *(const LAS s16x4*)xp, hh = *(const LAS s16x4*)(xp + 8);
                    const bf16x8 a = {lo[0], lo[1], lo[2], lo[3], hh[0], hh[1], hh[2], hh[3]};
                    o[pk] = MFMA32(a, pb[ks], o[pk]);
                }
        }
        {
            f32x16 o2[2] = {};
#pragma unroll
            for (int pk = 0; pk < 2; ++pk)
#pragma unroll
                for (int ks = 0; ks < 8; ++ks) {
                    const bf16x8 a = *(const LAS bf16x8*)(Hs + (32 * pk + c32) * 136 + 16 * ks + 8 * hi);
                    o2[pk] = MFMA32(a, qr[ks], o2[pk]);
                }
            const float el = __expf(acs_l);
#pragma unroll
            for (int pk = 0; pk < 2; ++pk)
#pragma unroll
                for (int r = 0; r < 16; ++r) o[pk][r] += el * o2[pk][r];
        }
        bf16_t* zrow = c.ymix() + (tok0 + l) * 2048 + h * 64; float ss = 0.f;
#pragma unroll
        for (int pk = 0; pk < 2; ++pk)
#pragma unroll
            for (int gq = 0; gq < 4; ++gq) {
                bf16_t* zp = zrow + 32 * pk + 8 * gq + 4 * hi; const u32x2 zz = *(const u32x2*)zp;
                const float y0 = o[pk][4 * gq] * silu_f(bflo(zz[0])), y1 = o[pk][4 * gq + 1] * silu_f(bfhi(zz[0]));
                const float y2 = o[pk][4 * gq + 2] * silu_f(bflo(zz[1])), y3 = o[pk][4 * gq + 3] * silu_f(bfhi(zz[1]));
                u32x2 w = {pk2(y0, y1), pk2(y2, y3)};
                const float r0 = bflo(w[0]), r1 = bfhi(w[0]), r2 = bflo(w[1]), r3 = bfhi(w[1]);
                ss += (r0 * r0 + r1 * r1) + (r2 * r2 + r3 * r3);
                *(u32x2*)(dummy ? c.hb() + (tok0 + l) * 1024 + h * 64 + 32 * pk + 8 * gq + 4 * hi : zp) = w;
            }
        ss += __shfl_xor(ss, 32);
        if (hi == 0) c.ssq()[(tok0 + l) * 16 + h] = ss;
        __syncthreads();
    }
}
DI void phase_final(const Ctx& c_in, const float* gain) {
    Ctx c = c_in; { int t_ = c.tid; asm volatile("" : "+v"(t_)); c.tid = t_; c.lane = t_ & 63; }
    const int gt = blockIdx.x * NTHR + c.tid, nt = gridDim.x * NTHR; float* hout = c.h();
    for (int i = gt; i < MTOK * 256; i += nt) {
        const int row = i >> 8, c4 = (i & 255) * 4; const float rs = row_rstd(c.ssp(), row);
        f32x4* p = (f32x4*)(hout + (size_t)row * DM + c4); const f32x4 g = *(const f32x4*)(gain + c4);
        *p = *p * rs * g;
    }
}

constexpr int PH_PER_LAYER = 12, N_PHASES = 2 + 2 * PH_PER_LAYER;
#ifndef PH_MASK
#define PH_MASK 0xffffffffu
#endif
#define KIND(q) (((PH_MASK) >> (q)) & 1u)
#define IN(k) (lo <= (k) && (k) < hi)
DI Ctx launder_ctx(const Ctx& c0) { Ctx c = c0; size_t z = 0; asm volatile("" : "+s"(z)); c.ws = c0.ws + z; return c; }
#define LC() launder_ctx(c0)
DI XcdBarrier make_bar(const Ctx& c0) { XcdBarrier b; size_t z = 0; asm volatile("" : "+s"(z)); unsigned char* w = c0.ws + z; b.bar = (unsigned*)(w + WS_CTL); b.x = xb_xcc_id(); b.st = (volatile LAS unsigned*)(c0.lds + LDS_BAR_OFF); return b; }
#define SEAM(k) do { if (IN(k) && IN((k) + 1)) xcd_barrier(make_bar(c0)); } while (0)
#ifndef PROBE_WC
#define PROBE_WC 1
#endif
#ifndef PROBE_FFNIN
#define PROBE_FFNIN 1
#endif
#ifndef PROBE_D1
#define PROBE_D1 1
#endif
#ifndef PROBE_SEL
#define PROBE_SEL 1
#endif
#ifndef PROBE_ATTN
#define PROBE_ATTN 0
#endif
#ifndef PROBE_S0
#define PROBE_S0 1
#endif
#ifndef PROBE_S1
#define PROBE_S1 1
#endif
#ifndef PROBE_S3
#define PROBE_S3 0
#endif
template <int layer> DI void layer_phases(const Ctx& c0, const int lo, const int hi) {
    const int G = (int)gridDim.x, bx = (int)blockIdx.x;
    constexpr int pb = 1 + layer * PH_PER_LAYER;
#define LP(i, stride) (argp(i) + (size_t)layer * (stride))
    if (KIND(1) && IN(pb + 0)) for (int rep = 0; rep < PROBE_WC; ++rep) {
        const Ctx c = LC();
        convert_w<1>(LC(), LP(3, (size_t)DM * NFFIN), DM, NFFIN, c.wb() + WB_1IN, NFFIN, LP(2, DM), DM, 1.0f);
        convert_w<0>(LC(), LP(4, (size_t)DFF * DM), DFF, DM, c.wb() + WB_1OUT, DM, nullptr, 0, 0.5f);
        convert_w<2>(LC(), LP(6, (size_t)DM * DINPROJ), DM, DINPROJ, c.wb() + WB_MIXB, NMIXB, LP(5, DM), DM, 1.0f);
        convert_w<0>(LC(), LP(6, (size_t)DM * DINPROJ), DM, DINPROJ, c.wb() + WB_MIXA, NMIXA, LP(5, DM), DM, 1.0f);
        convert_w<0>(LC(), LP(13, (size_t)2048 * DM), 2048, DM, c.wb() + WB_MO, DM, LP(12, DM), DM, 1.0f);
        convert_w<1>(LC(), LP(15, (size_t)DM * NFFIN), DM, NFFIN, c.wb() + WB_2IN, NFFIN, LP(14, DM), DM, 1.0f);
        convert_w<0>(LC(), LP(16, (size_t)DFF * DM), DFF, DM, c.wb() + WB_2OUT, DM, nullptr, 0, 0.5f);
    }
    SEAM(pb + 0);
#if PROBE_FFNIN > 1
    if (KIND(2) && IN(pb + 1)) {
        const Ctx c = LC(); pg8::Gemm g{c.hb(), c.wb() + WB_1IN, MTOK, NFFIN, DM}; pg8::StaticOrder S; S.init(MTOK, NFFIN, G, bx);
#if PROBE_FFNIN == 3
        EpiNull E{(float*)c.ymix()};
        pg8::gemm_phase<EpiNull, pg8::StaticOrder, false>(c.lds, g, S, E, nullptr);
#elif PROBE_FFNIN == 4
        EpiStoreOnly E{c.act()};
        pg8::gemm_phase<EpiStoreOnly, pg8::StaticOrder, false>(c.lds, g, S, E, nullptr);
#else
        EpiSwiGLU E{c.act(), c.ssp(), (LAS float*)(c.lds + RS_LDS_OFF)};
        pg8::gemm_phase<EpiSwiGLU, pg8::StaticOrder, false>(c.lds, g, S, E, nullptr);
#endif
    }
#endif
    if (KIND(2) && IN(pb + 1)) {
        const Ctx c = LC(); pg8::Gemm g{c.hb(), c.wb() + WB_1IN, MTOK, NFFIN, DM}; pg8::StaticOrder S; S.init(MTOK, NFFIN, G, bx);
        EpiSwiGLU E{c.act(), c.ssp(), (LAS float*)(c.lds + RS_LDS_OFF)};
        pg8::gemm_phase<EpiSwiGLU, pg8::StaticOrder, false>(c.lds, g, S, E, nullptr);
    }
    SEAM(pb + 1);
    if (KIND(3) && IN(pb + 2)) {
        const Ctx c = LC(); pg8::Gemm g{c.act(), c.wb() + WB_1OUT, MTOK, DM, DFF}; pg8::StaticOrder S; S.init(MTOK, DM, G, bx);
#ifdef PROBE_RES
        { EpiResid E0{layer == 0 ? c.x() : c.h(), (float*)c.ymix(), c.hb(), c.ssp(), nullptr, 1}; pg8::gemm_phase<EpiResid, pg8::StaticOrder, false>(c.lds, g, S, E0, nullptr); }
#endif
        EpiResid E{layer == 0 ? c.x() : c.h(), c.h(), c.hb(), c.ssp(), nullptr, 0};
        pg8::gemm_phase<EpiResid, pg8::StaticOrder, false>(c.lds, g, S, E, nullptr);
    }
    SEAM(pb + 2);
    if (KIND(4) && IN(pb + 3)) for (int rep = 0; rep < PROBE_D1; ++rep) {
        const Ctx c = LC(); pg8::Gemm g{c.hb(), c.wb() + WB_MIXB, MTOK, NMIXB, DM}; pg8::StaticOrder S; S.init(MTOK, NMIXB, G, bx);
        EpiMixB E{c.ssp(), c.ymix(), c.kbuf(), c.vbuf(), c.qi(), c.ki(), c.misc(), c.ropeA(), c.ropeI(), (LAS float*)(c.lds + RS_LDS_OFF)};
        pg8::gemm_phase<EpiMixB, pg8::StaticOrder, false>(c.lds, g, S, E, nullptr);
    }
    SEAM(pb + 3);
    if (KIND(6) && IN(pb + 4)) for (int rep = 0; rep < PROBE_SEL; ++rep) phase_select(LC());
    SEAM(pb + 4);
    if (KIND(7) && IN(pb + 5)) { if (PROBE_ATTN) phase_attn(LC(), 1); phase_attn(LC(), 0); }
    SEAM(pb + 5);
    if (KIND(5) && IN(pb + 6)) for (int rep = 0; rep < PROBE_S0; ++rep) {
        const Ctx c = LC(); pg8::Gemm g{c.hb(), c.wb() + WB_MIXA, MTOK, NMIXA, DM}; pg8::StaticOrder S; S.init(MTOK, NMIXA, G, bx);
        EpiMixA E{c.ssp(), c.ymix(), c.xbc(), (LAS float*)(c.lds + RS_LDS_OFF)};
        pg8::gemm_phase<EpiMixA, pg8::StaticOrder, false>(c.lds, g, S, E, nullptr);
    }
    SEAM(pb + 6);
    if (KIND(8) && IN(pb + 7)) for (int rep = 0; rep < PROBE_S1; ++rep) phase_ssd_states(LC(), LP(7, 4 * XBCW), LP(8, XBCW), LP(9, 16), LP(10, 16));
    SEAM(pb + 7);
    if (KIND(10) && IN(pb + 8)) { if (PROBE_S3) phase_ssd_out(LC(), LP(7, 4 * XBCW), LP(8, XBCW), LP(9, 16), LP(10, 16), LP(11, 16), 1); phase_ssd_out(LC(), LP(7, 4 * XBCW), LP(8, XBCW), LP(9, 16), LP(10, 16), LP(11, 16), 0); }
    SEAM(pb + 8);
    if (KIND(9) && IN(pb + 9)) {
        const Ctx c = LC(); pg8::Gemm g{c.ymix(), c.wb() + WB_MO, MTOK, DM, 2048}; pg8::StaticOrder S; S.init(MTOK, DM, G, bx);
        EpiResidKS E{c.h(), c.h(), c.hb(), c.ssp(), c.ssq(), 0};
        pg8::gemm_phase<EpiResidKS, pg8::StaticOrder, false>(c.lds, g, S, E, nullptr);
    }
    SEAM(pb + 9);
    if (KIND(2) && IN(pb + 10)) {
        const Ctx c = LC(); pg8::Gemm g{c.hb(), c.wb() + WB_2IN, MTOK, NFFIN, DM}; pg8::StaticOrder S; S.init(MTOK, NFFIN, G, bx);
        EpiSwiGLU E{c.act(), c.ssp(), (LAS float*)(c.lds + RS_LDS_OFF)};
        pg8::gemm_phase<EpiSwiGLU, pg8::StaticOrder, false>(c.lds, g, S, E, nullptr);
    }
    SEAM(pb + 10);
    if (KIND(3) && IN(pb + 11)) {
        const Ctx c = LC(); pg8::Gemm g{c.act(), c.wb() + WB_2OUT, MTOK, DM, DFF}; pg8::StaticOrder S; S.init(MTOK, DM, G, bx);
#ifdef PROBE_RES
        { EpiResid E0{c.h(), (float*)c.ymix(), c.hb(), c.ssp(), nullptr, 1}; pg8::gemm_phase<EpiResid, pg8::StaticOrder, false>(c.lds, g, S, E0, nullptr); }
#endif
        EpiResid E{c.h(), c.h(), c.hb(), c.ssp(), nullptr, 0};
        pg8::gemm_phase<EpiResid, pg8::StaticOrder, false>(c.lds, g, S, E, nullptr);
    }
    SEAM(pb + 11);
}
__global__ void __launch_bounds__(NTHR, 2) mk_fwd(Args args) {
    extern __shared__ __attribute__((aligned(16))) unsigned char lds_raw[];
    Ctx c;
    c.lds = (LAS unsigned char*)lds_raw; c.tid = threadIdx.x; c.lane = c.tid & 63; c.wid = __builtin_amdgcn_readfirstlane(c.tid >> 6);
    unsigned char* ws = args.ws; c.ws = ws;
    const int lo = args.ph_lo, hi = args.ph_hi;
    const bool multi = (hi - lo) > 1;
    if (c.tid == 0) *(LAS u32x4*)(c.lds + LDS_BAR_OFF) = (u32x4){0u, 0u, 0u, 0u};
    __syncthreads();
    if (multi) (void)xcd_barrier_post((unsigned*)(ws + WS_CTL), (volatile LAS unsigned*)(c.lds + LDS_BAR_OFF));
    const Ctx& c0 = c;

    if (KIND(0) && IN(0)) { phase_pro(LC()); } SEAM(0);
#ifdef PROBE_BAR
    if (multi) for (int rep = 0; rep < PROBE_BAR; ++rep) xcd_barrier(make_bar(c0));
#endif
    layer_phases<0>(c0, lo, hi);
    layer_phases<1>(c0, lo, hi);


    if (KIND(12) && IN(N_PHASES - 1)) phase_final(LC(), argp(17));
#undef IN
#undef SEAM
}

#ifndef MK_N_LAUNCHES
#define MK_N_LAUNCHES 1
#endif
extern "C" void kernel_launch(void* const* d_in, const int* in_sizes, int n_in, void* d_out, int out_size, void* d_ws, size_t ws_size, hipStream_t stream) {
    static int grid = 0;
    if (grid == 0) {
        if (n_in != 18 || out_size != MTOK * DM || ws_size < WS_END) { fprintf(stderr, "kernel_launch: unexpected shapes (n_in %d out %d ws %zu need %zu)\n", n_in, out_size, ws_size, (size_t)WS_END); grid = -1; return; }
        int dev = 0, cus = 0, per_cu = 0;
        if (hipGetDevice(&dev) != hipSuccess || hipDeviceGetAttribute(&cus, hipDeviceAttributeMultiprocessorCount, dev) != hipSuccess) { grid = -1; return; }
        if (hipFuncSetAttribute((const void*)mk_fwd, hipFuncAttributeMaxDynamicSharedMemorySize, LDS_BYTES) != hipSuccess) { fprintf(stderr, "kernel_launch: hipFuncSetAttribute failed\n"); grid = -1; return; }
        if (hipOccupancyMaxActiveBlocksPerMultiprocessor(&per_cu, (const void*)mk_fwd, NTHR, LDS_BYTES) != hipSuccess || per_cu < 1) fprintf(stderr, "kernel_launch: occupancy query says %d\n", per_cu);
        (void)hipGetLastError();
        grid = cus;
    }
    if (grid < 0) return;
    (void)hipMemsetAsync((char*)d_ws + WS_CTL, 0, 64 * 1024, stream);
    Args a{};
    for (int i = 0; i < 18; ++i) a.in[i] = (const float*)d_in[i];
    a.out = (float*)d_out; a.ws = (unsigned char*)d_ws;
    for (int f = 0; f < 16; ++f) a.invf[f] = (float)pow(500000.0, -(double)(2 * f) / 32.0);
    for (int f = 0; f < 8; ++f) a.invf[16 + f] = (float)pow(500000.0, -(double)(2 * f) / 16.0);
    if (MK_N_LAUNCHES == 1) {
        a.ph_lo = 0; a.ph_hi = N_PHASES;
        hipLaunchKernelGGL(mk_fwd, dim3(grid), dim3(NTHR), LDS_BYTES, stream, a);
    } else {
        for (int p = 0; p < N_PHASES; ++p) { a.ph_lo = p; a.ph_hi = p + 1; hipLaunchKernelGGL(mk_fwd, dim3(grid), dim3(NTHR), LDS_BYTES, stream, a); }
    }
}
```

```cpp
#include <hip/hip_runtime.h>
#include <cstdio>
#include <cstdint>
#include <cmath>

#define DI __device__ __forceinline__
#define LAS __attribute__((address_space(3)))
typedef unsigned short bf16_t;
typedef short bf16x8 __attribute__((ext_vector_type(8)));
typedef short s16x4 __attribute__((ext_vector_type(4)));
typedef float f32x2 __attribute__((ext_vector_type(2)));
typedef float f32x4 __attribute__((ext_vector_type(4)));
typedef float f32x16 __attribute__((ext_vector_type(16)));
typedef unsigned u32x2 __attribute__((ext_vector_type(2)));
typedef unsigned u32x4 __attribute__((ext_vector_type(4)));
typedef __bf16 bf2_t __attribute__((ext_vector_type(2)));

DI unsigned pk2(float a, float b) { bf2_t v = __builtin_convertvector((f32x2){a, b}, bf2_t); return __builtin_bit_cast(unsigned, v); }
DI bf16_t f2bf(float a) { return (bf16_t)(pk2(a, 0.f) & 0xffffu); }
DI float bf2f(bf16_t v) { return __uint_as_float(((unsigned)v) << 16); }
DI float bflo(unsigned w) { return __uint_as_float(w << 16); }
DI float bfhi(unsigned w) { return __uint_as_float(w & 0xffff0000u); }
DI bf16x8 pack8(f32x4 a, f32x4 b) { u32x4 w = {pk2(a[0], a[1]), pk2(a[2], a[3]), pk2(b[0], b[1]), pk2(b[2], b[3])}; return __builtin_bit_cast(bf16x8, w); }
DI float silu_f(float x) { return x * __builtin_amdgcn_rcpf(1.0f + __builtin_amdgcn_exp2f(-1.4426950408889634f * x)); }
DI int crow(int r, int hi) { return (r & 3) + 8 * (r >> 2) + 4 * hi; }
#define MFMA32(a, b, c) __builtin_amdgcn_mfma_f32_32x32x16_bf16((a), (b), (c), 0, 0, 0)

constexpr int NB = 4, SEQ = 4096, MTOK = NB * SEQ, DM = 1024, DFF = 2816, NFFIN = 2 * DFF;
constexpr int NMIXB = 3840, NMIXA = 2560, DINPROJ = 6232, XBCW = 1536;
constexpr int NTHR = 512;
constexpr int HBP = DM + 64, YP = 2048 + 64, KVP = 1024 + 64, QIP = 512 + 64, XBP = XBCW + 64, ACTP = DFF + 64;
constexpr float EPS = 1e-6f;
constexpr int LDS_BYTES = 147456;
constexpr int LDS_BAR_OFF = LDS_BYTES - 16;

constexpr size_t KiB = 1024, MiB = 1024 * 1024;
constexpr size_t WS_CTL = 0;
constexpr size_t WS_SSP = 64 * KiB;
constexpr size_t WS_ROPEA = WS_SSP + 1 * MiB;
constexpr size_t WS_ROPEI = WS_ROPEA + 2 * MiB;
constexpr size_t WS_SSQ = WS_ROPEI + 1 * MiB;
constexpr size_t WS_CDEC = WS_SSQ + 1 * MiB;
constexpr size_t WS_WB = WS_CDEC + 64 * KiB;
constexpr size_t WS_HB = WS_WB + 50 * MiB;
constexpr size_t WS_YMIX = WS_HB + 34 * MiB;
constexpr size_t WS_MISC = WS_YMIX + 66 * MiB;
constexpr size_t WS_R = WS_MISC + 2 * MiB;
constexpr size_t WS_END = WS_R + 96 * MiB;
static_assert(WS_END <= 256 * MiB, "workspace");
constexpr size_t R_K = 0, R_V = 34 * MiB, R_QI = 68 * MiB, R_KI = 86 * MiB, R_MASK = 88 * MiB;
constexpr size_t R_XBC = 0, R_STATES = 50 * MiB;
constexpr size_t R_ACT = 0;
constexpr size_t WB_1IN = 0, WB_1OUT = WB_1IN + (size_t)NFFIN * DM, WB_MIXB = WB_1OUT + (size_t)DM * DFF, WB_MIXA = WB_MIXB + (size_t)NMIXB * DM,
                 WB_MO = WB_MIXA + (size_t)NMIXA * DM, WB_2IN = WB_MO + (size_t)DM * 2048, WB_2OUT = WB_2IN + (size_t)NFFIN * DM, WB_END = WB_2OUT + (size_t)DM * DFF;
static_assert(WB_END * 2 <= 50 * MiB, "weights");

struct Args { const float* in[18]; float* out; unsigned char* ws; float invf[24]; int ph_lo, ph_hi; };

typedef const __attribute__((address_space(4))) unsigned char* kargp_t;
DI kargp_t karg_base() { kargp_t ka = (kargp_t)__builtin_amdgcn_kernarg_segment_ptr(); asm volatile("" : "+s"(ka)); return ka; }
#define GLOBAL_AS __attribute__((address_space(1)))
template <class T> DI T* as_global(T* p) { return (T*)(GLOBAL_AS T*)p; }
DI const float* argp(int i) { return *(const float* const __attribute__((address_space(4)))*)(karg_base() + 8 * i); }
struct Ctx {
    LAS unsigned char* lds; int tid, lane, wid; unsigned char* ws;
    DI const float* x() const { return argp(0); }
    DI const int* pos() const { return (const int*)argp(1); }
    DI float* h() const { return (float*)argp(18); }
    DI float* ssp() const { return (float*)(ws + WS_SSP); }
    DI f32x2* ropeA() const { return (f32x2*)(ws + WS_ROPEA); }
    DI f32x2* ropeI() const { return (f32x2*)(ws + WS_ROPEI); }
    DI float* ssq() const { return (float*)(ws + WS_SSQ); }
    DI float* cdec() const { return (float*)(ws + WS_CDEC); }
    DI bf16_t* wb() const { return (bf16_t*)(ws + WS_WB); }
    DI bf16_t* hb() const { return (bf16_t*)(ws + WS_HB); }
    DI bf16_t* ymix() const { return (bf16_t*)(ws + WS_YMIX); }
    DI float* misc() const { return (float*)(ws + WS_MISC); }
    DI bf16_t* kbuf() const { return (bf16_t*)(ws + WS_R + R_K); }
    DI bf16_t* vbuf() const { return (bf16_t*)(ws + WS_R + R_V); }
    DI bf16_t* qi() const { return (bf16_t*)(ws + WS_R + R_QI); }
    DI bf16_t* ki() const { return (bf16_t*)(ws + WS_R + R_KI); }
    DI unsigned* mask() const { return (unsigned*)(ws + WS_R + R_MASK); }
    DI bf16_t* xbc() const { return (bf16_t*)(ws + WS_R + R_XBC); }
    DI float* states() const { return (float*)(ws + WS_R + R_STATES); }
    DI bf16_t* act() const { return (bf16_t*)(ws + WS_R + R_ACT); }
};

DI float row_rstd(const float* ssp, int row) {
    const f32x4* p = (const f32x4*)(ssp + (size_t)row * 16);
    const f32x4 a = p[0], b = p[1], c = p[2], d = p[3];
    const float s = ((a[0] + a[1]) + (a[2] + a[3])) + ((b[0] + b[1]) + (b[2] + b[3])) + ((c[0] + c[1]) + (c[2] + c[3])) + ((d[0] + d[1]) + (d[2] + d[3]));
    return rsqrtf(s * (1.0f / 1024.0f) + EPS);
}
namespace pg8 {
#define PG8_LAS __attribute__((address_space(3)))
typedef unsigned short bf16_t;
typedef short bf16x8 __attribute__((ext_vector_type(8)));
typedef float f32x4 __attribute__((ext_vector_type(4)));
typedef unsigned u32x4 __attribute__((ext_vector_type(4)));
constexpr int BM = 256, BK = 64, HALF = 128, HTB = HALF * BK * 2  , STAGE_BYTES = 8 * HTB, NXCD = 8, WGM = 8;

__host__ __device__ __forceinline__ int lds_byte(int r, int c) { const int st = (r >> 4) * 2 + (c >> 5), rr = r & 15, cc = c & 31, ob = rr * 64 + cc * 2; return st * 1024 + (ob ^ (((ob >> 9) & 1) << 5)); }
__host__ __device__ __forceinline__ void stage_rc(int b, int& R, int& C) { const int st = b / 1024, sb = b % 1024, swz = sb ^ (((sb >> 9) & 1) << 5); R = (st >> 1) * 16 + swz / 64; C = (st & 1) * 32 + (swz % 64) / 2; }
__host__ __device__ __forceinline__ int perm32(int rho) { const int n = rho >> 4, i = rho & 15; return 8 * (i >> 2) + 4 * n + (i & 3); }

struct Unit { int pm, pn; };
struct Gemm { const bf16_t* A; const bf16_t* Bt; int M, N, K, lda; };

struct StaticOrder {
    int nM, nN, nwg, G, c;
    __host__ __device__ void init(int M, int N, int G_, int c_) { nM = M / BM; nN = N / BM; nwg = nM * nN; G = G_; c = c_; }
    __host__ __device__ bool next(int i, Unit& u) const {
        const long L = (long)i * G + c; if (L >= nwg) return false;
        int wgid = (int)L; { const int q = nwg / NXCD, r = nwg % NXCD, xcd = wgid % NXCD, off = wgid / NXCD; wgid = (xcd < r ? xcd * (q + 1) : r * (q + 1) + (xcd - r) * q) + off; }
        const int nig = WGM * nN, gid = wgid / nig, fm = gid * WGM, gsz = (nM - fm) < WGM ? (nM - fm) : WGM;
        u.pm = fm + ((wgid % nig) % gsz); u.pn = (wgid % nig) / gsz; return true;
    }
    __device__ __forceinline__ void a_ready(const Unit&) const {}
    __device__ __forceinline__ void done(const Unit&) const {}
};
template <class Epi, class Sched, bool STAMP = false>
__device__ __forceinline__ void gemm_phase(PG8_LAS unsigned char* lds, const Gemm g, const Sched& S, const Epi& E, unsigned long long* stamps) {
    int tid_ = threadIdx.x; asm volatile("" : "+v"(tid_));
    const int tid = tid_, wid = __builtin_amdgcn_readfirstlane(tid >> 6), lane = tid & 63, wr = wid >> 2, wc = wid & 3, fr = lane & 15, fq = lane >> 4;
    const int K = g.K, nt = K / BK, lda = g.lda;
    int ts_lo = 0, ts_hi = 0, nts = 0; const unsigned long long rt_entry = STAMP ? (unsigned long long)wall_clock64() : 0ull;
#define PG8_STAMP() do { if (STAMP && wid == 0 && nts < 64) { const unsigned long long _c = (unsigned long long)clock64(); \
        ts_lo = (lane == nts) ? (int)(unsigned)_c : ts_lo; ts_hi = (lane == nts) ? (int)(unsigned)(_c >> 32) : ts_hi; ++nts; } } while (0)
    PG8_STAMP();
    unsigned voffA[2], voffB[2];
#pragma unroll
    for (int i = 0; i < 2; ++i) { int R, C; stage_rc(tid * 16 + i * 8192, R, C); const int Rb = Epi::PERM ? ((R & ~31) + perm32(R & 31)) : R;
        voffA[i] = (unsigned)(R * lda + C) * 2u; voffB[i] = (unsigned)(Rb * K + C) * 2u; }
    const size_t kstep = (size_t)(BK * 2);
    const size_t hstepA = (size_t)HALF * lda * 2, tstepA = 2 * hstepA;
    const size_t hstep = (size_t)HALF * K * 2;
    const size_t tstep = 2 * hstep;
    const unsigned ldsw = (unsigned)wid * 1024u;
    const int aoff = lds_byte(wr * 64 + fr, fq * 8), boff = lds_byte(wc * 32 + fr, fq * 8);
#define PG8_SA(b, h) (((b) * 2 + (h)) * HTB)
#define PG8_SB(b, h) ((4 + (b) * 2 + (h)) * HTB)
#define PG8_STAGE(bufoff, gbase, voff) do { _Pragma("unroll") for (int _i = 0; _i < 2; ++_i) \
        __builtin_amdgcn_global_load_lds((const unsigned*)((const char*)(gbase) + (voff)[_i]), (PG8_LAS unsigned*)(lds + (bufoff) + ldsw + _i * 8192), 16, 0, 0); } while (0)
#define PG8_LDA(dst, b, h) do { _Pragma("unroll") for (int m = 0; m < 4; ++m) _Pragma("unroll") for (int k = 0; k < 2; ++k) dst[m][k] = *(const PG8_LAS bf16x8*)(lds + PG8_SA(b, h) + aoff + m * 2048 + k * 1024); } while (0)
#define PG8_LDB(dst, b, h) do { _Pragma("unroll") for (int n = 0; n < 2; ++n) _Pragma("unroll") for (int k = 0; k < 2; ++k) dst[n][k] = *(const PG8_LAS bf16x8*)(lds + PG8_SB(b, h) + boff + n * 2048 + k * 1024); } while (0)
#define PG8_MMA(ai, bj, At, Bt) do { __builtin_amdgcn_s_setprio(1); _Pragma("unroll") for (int m = 0; m < 4; ++m) _Pragma("unroll") for (int n = 0; n < 2; ++n) _Pragma("unroll") for (int k = 0; k < 2; ++k) \
        acc[ai][bj][m][n] = __builtin_amdgcn_mfma_f32_16x16x32_bf16(Bt[n][k], At[m][k], acc[ai][bj][m][n], 0, 0, 0); __builtin_amdgcn_s_setprio(0); } while (0)
#define PG8_WAIT_V(n) asm volatile("s_waitcnt vmcnt(" #n ")" ::: "memory")
#define PG8_WAIT_L(n) asm volatile("s_waitcnt lgkmcnt(" #n ")" ::: "memory")
#define PG8_BAR __builtin_amdgcn_s_barrier()
#define PG8_SCHED __builtin_amdgcn_sched_barrier(0)
    Unit cur, nxt; int ui = 0; f32x4 pr0 = {0.f, 0.f, 0.f, 0.f}, pr1 = pr0;
    if (!S.next(0, cur)) return;
    f32x4 acc[2][2][4][2];
#pragma unroll
    for (int a = 0; a < 2; ++a)
#pragma unroll
        for (int b = 0; b < 2; ++b)
#pragma unroll
            for (int m = 0; m < 4; ++m)
#pragma unroll
                for (int n = 0; n < 2; ++n) acc[a][b][m][n] = (f32x4){0.f, 0.f, 0.f, 0.f};
    bf16x8 At[4][2], B0[2][2], B1[2][2];
    const char* cA = (const char*)g.A + (size_t)cur.pm * tstepA; const char* cB = (const char*)g.Bt + (size_t)cur.pn * tstep;
    S.a_ready(cur);
    if constexpr (Epi::PREP) E.prep(cur, 0, tid);
    PG8_STAGE(PG8_SB(0, 0), cB, voffB); PG8_STAGE(PG8_SA(0, 0), cA, voffA); PG8_STAGE(PG8_SB(0, 1), cB + hstep, voffB); PG8_STAGE(PG8_SA(0, 1), cA + hstepA, voffA);
    if (wr == 1) PG8_BAR;
    PG8_WAIT_V(4); PG8_BAR;
    PG8_STAGE(PG8_SB(1, 0), cB + kstep, voffB); PG8_STAGE(PG8_SA(1, 0), cA + kstep, voffA); PG8_STAGE(PG8_SB(1, 1), cB + hstep + kstep, voffB);
    PG8_WAIT_V(6); PG8_BAR;
    PG8_STAMP();
    for (;;) {
        const bool has_next = S.next(ui + 1, nxt);
        const char* nA = has_next ? (const char*)g.A + (size_t)nxt.pm * tstepA : cA; const char* nB = has_next ? (const char*)g.Bt + (size_t)nxt.pn * tstep : cB;
        for (int t = 0; t < nt; t += 2) {
            if constexpr (Epi::KSCALE) { if (t == 8 || t == 16) E.kscale(acc, cur, t, wr, fr); }
            const bool last = (t == nt - 2);
            const char* a1 = cA + (size_t)(t + 1) * kstep;
            const char* a2 = last ? nA : cA + (size_t)(t + 2) * kstep; const char* b2 = last ? nB : cB + (size_t)(t + 2) * kstep;
            const char* a3 = a2 + kstep; const char* b3 = b2 + kstep;
            if (last && has_next) { S.a_ready(nxt); if constexpr (Epi::PREP) E.prep_issue(nxt, tid, pr0, pr1); }
            PG8_LDB(B0, 0, 0); PG8_SCHED; PG8_LDA(At, 0, 0); PG8_STAGE(PG8_SA(1, 1), a1 + hstepA, voffA);
            PG8_WAIT_L(8); PG8_BAR; PG8_WAIT_L(0); PG8_MMA(0, 0, At, B0); PG8_BAR; PG8_SCHED;
            PG8_LDB(B1, 0, 1); PG8_STAGE(PG8_SB(0, 0), b2, voffB);
            PG8_BAR; PG8_WAIT_L(0); PG8_MMA(0, 1, At, B1); PG8_BAR;
            PG8_LDA(At, 0, 1); PG8_STAGE(PG8_SA(0, 0), a2, voffA);
            PG8_BAR; PG8_WAIT_L(0); PG8_MMA(1, 0, At, B0); PG8_BAR; PG8_SCHED;
            PG8_STAGE(PG8_SB(0, 1), b2 + hstep, voffB);
            PG8_WAIT_V(6); PG8_BAR; PG8_MMA(1, 1, At, B1); PG8_BAR;
            PG8_LDB(B0, 1, 0); PG8_SCHED; PG8_LDA(At, 1, 0); PG8_STAGE(PG8_SA(0, 1), a2 + hstepA, voffA);
            PG8_WAIT_L(8); PG8_BAR; PG8_WAIT_L(0); PG8_MMA(0, 0, At, B0); PG8_BAR; PG8_SCHED;
            PG8_LDB(B1, 1, 1); PG8_STAGE(PG8_SB(1, 0), b3, voffB);
            PG8_BAR; PG8_WAIT_L(0); PG8_MMA(0, 1, At, B1); PG8_BAR;
            PG8_LDA(At, 1, 1); PG8_STAGE(PG8_SA(1, 0), a3, voffA);
            PG8_BAR; PG8_WAIT_L(0); PG8_MMA(1, 0, At, B0); PG8_BAR; PG8_SCHED;
            PG8_STAGE(PG8_SB(1, 1), b3 + hstep, voffB);
            PG8_WAIT_V(6); PG8_BAR; PG8_MMA(1, 1, At, B1); PG8_BAR;
        }
        PG8_STAMP();
        if constexpr (Epi::PREP) { if (has_next) E.prep_finish((ui + 1) & 1, tid, pr0, pr1); }
        if constexpr (!Epi::AFTER_DRAIN) { if constexpr (Epi::PREP) E(acc, cur, wr, wc, fr, fq, ui & 1); else E(acc, cur, wr, wc, fr, fq); S.done(cur); }
        PG8_STAMP();
        if (!has_next) break;
#pragma unroll
        for (int a = 0; a < 2; ++a)
#pragma unroll
            for (int b = 0; b < 2; ++b)
#pragma unroll
                for (int m = 0; m < 4; ++m)
#pragma unroll
                    for (int n = 0; n < 2; ++n) acc[a][b][m][n] = (f32x4){0.f, 0.f, 0.f, 0.f};
        cur = nxt; cA = nA; cB = nB; ++ui;
    }
    PG8_WAIT_V(0);
    if (wr == 0) PG8_BAR;
    PG8_BAR;
    if constexpr (Epi::AFTER_DRAIN) { E.fused(acc, cur, wr, wc, fr, fq, lds, wid, lane); S.done(cur); }
    PG8_STAMP();
    if (STAMP && wid == 0) { stamps[lane] = lane < nts ? (((unsigned long long)(unsigned)ts_hi << 32) | (unsigned)ts_lo) : 0ull;
        if (lane == 62) stamps[62] = rt_entry; if (lane == 63) stamps[63] = (unsigned long long)wall_clock64(); }
#undef PG8_STAMP
#undef PG8_SA
#undef PG8_SB
#undef PG8_STAGE
#undef PG8_LDA
#undef PG8_LDB
#undef PG8_MMA
#undef PG8_WAIT_V
#undef PG8_WAIT_L
#undef PG8_BAR
#undef PG8_SCHED
}
}
#define XB_TMO      128
#define XB_XCNT(j)  (256  + 64 * (j))
#define XB_XSUB(j)  (1280 + 64 * (j))
#define XB_XGEN(j)  (2304 + 64 * (j))
#define XB_TOP      3328
#define XB_TOPGEN   3392
#define XCD_BAR_WORDS 3456
#define XB_SPIN_CAP (1u << 18)
#define LAS __attribute__((address_space(3)))

__device__ __forceinline__ unsigned xb_ld(unsigned* p)              { return __hip_atomic_load(p, __ATOMIC_RELAXED, __HIP_MEMORY_SCOPE_AGENT); }
__device__ __forceinline__ unsigned xb_add(unsigned* p, unsigned v) { return __hip_atomic_fetch_add(p, v, __ATOMIC_RELAXED, __HIP_MEMORY_SCOPE_AGENT); }
__device__ __forceinline__ unsigned xb_xcc_id() { return (unsigned)__builtin_amdgcn_s_getreg((3 << 11) | 20) & 0xFu; }
#define XB_SPIN(cond, bar) do { unsigned _sp = 0; while (cond) { __builtin_amdgcn_s_sleep(1); \
    if ((++_sp & 255u) == 0u) { if (xb_ld(&(bar)[XB_TMO])) break; if (_sp > XB_SPIN_CAP) { atomicAdd(&(bar)[XB_TMO], 1u); break; } } } } while (0)

struct XcdBarrier {
    unsigned* bar; unsigned x;
    volatile LAS unsigned* st;
};

__device__ __forceinline__ XcdBarrier xcd_barrier_post(unsigned* bar, volatile LAS unsigned* st) {
    XcdBarrier b; b.bar = bar; b.x = xb_xcc_id(); b.st = st;
    if (threadIdx.x == 0) (void)xb_add(&bar[XB_XCNT(b.x)], 1u);
    return b;
}
__device__ __forceinline__ void xcd_barrier_complete(unsigned* bar, unsigned x, unsigned& nloc, unsigned& nx) {
    const unsigned G = gridDim.x * gridDim.y * gridDim.z;
    unsigned sum, cnt, mine, sp = 0u;
    for (;;) {
        sum = 0u; cnt = 0u; mine = 0u;
#pragma unroll
        for (unsigned j = 0; j < 16; ++j) { const unsigned c = xb_ld(&bar[XB_XCNT(j)]); sum += c; cnt += (c > 0u) ? 1u : 0u; mine = (j == x) ? c : mine; }
        if (sum == G) break;
        __builtin_amdgcn_s_sleep(1);
        if ((++sp & 255u) == 0u) { if (xb_ld(&bar[XB_TMO])) break; if (sp > XB_SPIN_CAP) { atomicAdd(&bar[XB_TMO], 1u); break; } }
    }
    nloc = mine > 0u ? mine : 1u; nx = cnt > 0u ? cnt : 1u;
}

__device__ __forceinline__ void xcd_barrier(const XcdBarrier& b) {
    asm volatile("s_waitcnt vmcnt(0)" ::: "memory");
    __syncthreads();
    if (threadIdx.x == 0) {
        unsigned* bar = b.bar;
        __builtin_amdgcn_s_waitcnt(0);
        unsigned nloc = b.st[0], nx = b.st[1];
        if (nloc == 0u) { xcd_barrier_complete(bar, b.x, nloc, nx); b.st[0] = nloc; b.st[1] = nx; }
        const unsigned old = xb_add(&bar[XB_XSUB(b.x)], 1u);
        const unsigned gen = old / nloc;
        if (old + 1u == (gen + 1u) * nloc) {
            __builtin_amdgcn_fence(__ATOMIC_RELEASE, "agent");
            asm volatile("s_waitcnt vmcnt(0)" ::: "memory");
            const unsigned og = xb_add(&bar[XB_TOP], 1u);
            const unsigned tg = og / nx;
            if (og + 1u == (tg + 1u) * nx) xb_add(&bar[XB_TOPGEN], 1u);
            else XB_SPIN(xb_ld(&bar[XB_TOPGEN]) == tg, bar);
            __builtin_amdgcn_fence(__ATOMIC_ACQUIRE, "agent");
            xb_add(&bar[XB_XGEN(b.x)], 1u);
            asm volatile("s_waitcnt vmcnt(0)" ::: "memory");
        } else {
            XB_SPIN(xb_ld(&bar[XB_XGEN(b.x)]) == gen, bar);
            __builtin_amdgcn_fence(__ATOMIC_ACQUIRE, "agent");
            asm volatile("s_waitcnt vmcnt(0)" ::: "memory");
        }
    }
    __syncthreads();
}

constexpr int RS_LDS_OFF = 131072;
DI void prep_rstd(const float* ssp, LAS float* tab, int pm, int par, int tid) {
    const int row = tid >> 1, hf = tid & 1;
    const f32x4* p = (const f32x4*)(ssp + (size_t)(pm * 256 + row) * 16 + hf * 8);
    const f32x4 a = p[0], b = p[1];
    float s = ((a[0] + a[1]) + (a[2] + a[3])) + ((b[0] + b[1]) + (b[2] + b[3]));
    s += __shfl_xor(s, 1);
    if (hf == 0) tab[par * 256 + row] = rsqrtf(s * (1.0f / 1024.0f) + EPS);
}
DI void prep_rstd_issue(const float* ssp, int pm, int tid, f32x4& a, f32x4& b) {
    const int row = tid >> 1, hf = tid & 1; const f32x4* p = (const f32x4*)(ssp + (size_t)(pm * 256 + row) * 16 + hf * 8); a = p[0]; b = p[1];
}
DI void prep_rstd_finish(LAS float* tab, int par, int tid, const f32x4& a, const f32x4& b) {
    const int row = tid >> 1, hf = tid & 1;
    float s = ((a[0] + a[1]) + (a[2] + a[3])) + ((b[0] + b[1]) + (b[2] + b[3]));
    s += __shfl_xor(s, 1);
    if (hf == 0) tab[par * 256 + row] = rsqrtf(s * (1.0f / 1024.0f) + EPS);
}
struct EpiSwiGLU {
    static constexpr bool PERM = true, AFTER_DRAIN = false, KSCALE = false, PREP = true;
    bf16_t* act; const float* ssp; LAS float* tab;
    DI void prep(const pg8::Unit& u, int par, int tid) const { prep_rstd(ssp, tab, u.pm, par, tid); }
    DI void prep_issue(const pg8::Unit& u, int tid, f32x4& a, f32x4& b) const { prep_rstd_issue(ssp, u.pm, tid, a, b); }
    DI void prep_finish(int par, int tid, const f32x4& a, const f32x4& b) const { prep_rstd_finish(tab, par, tid, a, b); }
    DI void operator()(const f32x4 (&acc)[2][2][4][2], const pg8::Unit& u, int wr, int wc, int fr, int fq, int par) const {
        const int row0 = u.pm * 256 + wr * 64 + fr, col = u.pn * 128 + wc * 32 + 8 * fq;
#pragma unroll
        for (int ai = 0; ai < 2; ++ai)
#pragma unroll
            for (int m = 0; m < 4; ++m) {
                const int row = row0 + ai * 128 + m * 16; const float rs = tab[par * 256 + ai * 128 + wr * 64 + m * 16 + fr];
                float o[8];
#pragma unroll
                for (int n = 0; n < 2; ++n)
#pragma unroll
                    for (int e = 0; e < 4; ++e) o[n * 4 + e] = silu_f(acc[ai][0][m][n][e] * rs) * (acc[ai][1][m][n][e] * rs);
                u32x4 w = {pk2(o[0], o[1]), pk2(o[2], o[3]), pk2(o[4], o[5]), pk2(o[6], o[7])};
                *(u32x4*)(act + (size_t)row * ACTP + col) = w;
                asm volatile("" ::: "memory");
            }
    }
};
template <bool KS> struct EpiResidT {
    static constexpr bool PERM = false, AFTER_DRAIN = false, KSCALE = KS, PREP = false;
    const float* hin; float* hout; bf16_t* hb; float* ssp; const float* ssq; int dummy;
    DI void kscale(f32x4 (&acc)[2][2][4][2], const pg8::Unit& u, int t, int wr, int fr) const {
        int fr_ = fr; asm volatile("" : "+v"(fr_));
        const int row0 = u.pm * 256 + wr * 64 + fr_;
#pragma unroll
        for (int ai = 0; ai < 2; ++ai)
#pragma unroll
            for (int m = 0; m < 4; ++m) {
                const f32x4* sp = (const f32x4*)(ssq + (size_t)(row0 + ai * 128 + m * 16) * 16);
                const f32x4 a = sp[0], b = sp[1], c = sp[2], d = sp[3];
                const float v0 = ((a[0] + a[1]) + (a[2] + a[3]) + (b[0] + b[1]) + (b[2] + b[3])) * (1.0f / 512.0f) + EPS;
                const float v1 = ((c[0] + c[1]) + (c[2] + c[3]) + (d[0] + d[1]) + (d[2] + d[3])) * (1.0f / 512.0f) + EPS;
                const float f = (t == 8) ? rsqrtf(v0) * sqrtf(v1) : rsqrtf(v1);
#pragma unroll
                for (int bj = 0; bj < 2; ++bj)
#pragma unroll
                    for (int n = 0; n < 2; ++n) acc[ai][bj][m][n] *= f;
                asm volatile("" ::: "memory");
            }
    }
    DI void operator()(const f32x4 (&acc)[2][2][4][2], const pg8::Unit& u, int wr, int wc, int fr, int fq) const {
        const int row0 = u.pm * 256 + wr * 64 + fr, col0 = u.pn * 256 + wc * 32 + 4 * fq;
#pragma unroll
        for (int ai = 0; ai < 2; ++ai)
#pragma unroll
            for (int m = 0; m < 4; ++m) {
                const int row = row0 + ai * 128 + m * 16; float ss = 0.f;
#pragma unroll
                for (int bj = 0; bj < 2; ++bj)
#pragma unroll
                    for (int n = 0; n < 2; ++n) {
                        const size_t off = (size_t)row * DM + col0 + bj * 128 + n * 16;
                        f32x4 hv = *(const f32x4*)(hin + off); hv += acc[ai][bj][m][n];
                        *(f32x4*)(hout + off) = hv;
                        u32x2 w = {pk2(hv[0], hv[1]), pk2(hv[2], hv[3])}; if (!dummy) *(u32x2*)(hb + (size_t)row * HBP + col0 + bj * 128 + n * 16) = w;
                        ss += (hv[0] * hv[0] + hv[1] * hv[1]) + (hv[2] * hv[2] + hv[3] * hv[3]);
                    }
                ss += __shfl_xor(ss, 16); ss += __shfl_xor(ss, 32);
                if (fq == 0 && !dummy) ssp[(size_t)row * 16 + u.pn * 4 + wc] = ss;
                asm volatile("" ::: "memory");
            }
    }
};
typedef EpiResidT<false> EpiResid;
typedef EpiResidT<true> EpiResidKS;
template <bool USE_PREP> struct EpiMixAT {
    static constexpr bool PERM = true, AFTER_DRAIN = false, KSCALE = false, PREP = USE_PREP;
    const float* ssp; bf16_t* ymix; bf16_t* xbc; LAS float* tab;
    DI void prep(const pg8::Unit& u, int par, int tid) const { prep_rstd(ssp, tab, u.pm, par, tid); }
    DI void prep_issue(const pg8::Unit& u, int tid, f32x4& a, f32x4& b) const { prep_rstd_issue(ssp, u.pm, tid, a, b); }
    DI void prep_finish(int par, int tid, const f32x4& a, const f32x4& b) const { prep_rstd_finish(tab, par, tid, a, b); }
    DI void operator()(const f32x4 (&acc)[2][2][4][2], const pg8::Unit& u, int wr, int wc, int fr, int fq) const { (*this)(acc, u, wr, wc, fr, fq, 0); }
    DI void operator()(const f32x4 (&acc)[2][2][4][2], const pg8::Unit& u, int wr, int wc, int fr, int fq, int par) const {
        const int row0 = u.pm * 256 + wr * 64 + fr, colt = wc * 32 + 8 * fq; const int pn = u.pn;
        bf16_t* dst; int ld;
        if (pn < 4) { dst = ymix + pn * 256; ld = YP; } else { dst = xbc + (pn - 4) * 256; ld = XBP; }
#pragma unroll
        for (int ai = 0; ai < 2; ++ai)
#pragma unroll
            for (int m = 0; m < 4; ++m) {
                const int row = row0 + ai * 128 + m * 16; const float rs = USE_PREP ? tab[par * 256 + ai * 128 + wr * 64 + m * 16 + fr] : 1.0f;
#pragma unroll
                for (int bj = 0; bj < 2; ++bj) {
                    const f32x4 a = acc[ai][bj][m][0] * rs, b = acc[ai][bj][m][1] * rs;
                    u32x4 w = {pk2(a[0], a[1]), pk2(a[2], a[3]), pk2(b[0], b[1]), pk2(b[2], b[3])};
                    *(u32x4*)(dst + (size_t)row * ld + bj * 128 + colt) = w;
                }
                asm volatile("" ::: "memory");
            }
    }
};
typedef EpiMixAT<true> EpiMixA;
DI u32x4 pk8(const float (&v)[8]) { u32x4 w = {pk2(v[0], v[1]), pk2(v[2], v[3]), pk2(v[4], v[5]), pk2(v[6], v[7])}; return w; }
struct EpiMixB {
    static constexpr bool PERM = true, AFTER_DRAIN = false, KSCALE = false, PREP = true;
    const float* ssp; bf16_t* ymix; bf16_t* kbuf; bf16_t* vbuf; bf16_t* qi; bf16_t* ki; float* misc; const f32x2* ropeA; const f32x2* ropeI; LAS float* tab;
    DI void prep(const pg8::Unit& u, int par, int tid) const { prep_rstd(ssp, tab, u.pm, par, tid); }
    DI void prep_issue(const pg8::Unit& u, int tid, f32x4& a, f32x4& b) const { prep_rstd_issue(ssp, u.pm, tid, a, b); }
    DI void prep_finish(int par, int tid, const f32x4& a, const f32x4& b) const { prep_rstd_finish(tab, par, tid, a, b); }
    DI void operator()(const f32x4 (&acc)[2][2][4][2], const pg8::Unit& u, int wr, int wc, int fr, int fq, int par) const {
        const int row0 = u.pm * 256 + wr * 64 + fr, pos0 = wc * 32 + 8 * fq; const int pn = u.pn;
#pragma unroll
        for (int ai = 0; ai < 2; ++ai)
#pragma unroll
            for (int m = 0; m < 4; ++m) {
                const int row = row0 + ai * 128 + m * 16; const float rs = tab[par * 256 + ai * 128 + wr * 64 + m * 16 + fr];
                float X[8], Y[8];
#pragma unroll
                for (int e = 0; e < 4; ++e) { X[e] = acc[ai][0][m][0][e] * rs; X[4 + e] = acc[ai][0][m][1][e] * rs; Y[e] = acc[ai][1][m][0][e] * rs; Y[4 + e] = acc[ai][1][m][1][e] * rs; }
                if (pn < 8) {
                    bf16_t* base = (pn < 4) ? ymix + (size_t)row * YP + 1024 + pn * 256 : kbuf + (size_t)row * KVP + (pn - 4) * 256;
                    if (wc == 0) {
                        const int f0 = (8 * fq) & 15; const f32x4* cp = (const f32x4*)(ropeA + (size_t)row * 16 + f0);
                        float ox[8], oy[8];
#pragma unroll
                        for (int e2 = 0; e2 < 4; ++e2) { const f32x4 cs = cp[e2];
                            ox[2 * e2] = X[2 * e2] * cs[0] - Y[2 * e2] * cs[1]; oy[2 * e2] = Y[2 * e2] * cs[0] + X[2 * e2] * cs[1];
                            ox[2 * e2 + 1] = X[2 * e2 + 1] * cs[2] - Y[2 * e2 + 1] * cs[3]; oy[2 * e2 + 1] = Y[2 * e2 + 1] * cs[2] + X[2 * e2 + 1] * cs[3]; }
                        bf16_t* hp = base + (fq >> 1) * 128 + f0;
                        *(u32x4*)hp = pk8(ox); *(u32x4*)(hp + 16) = pk8(oy);
                    } else { *(u32x4*)(base + pos0) = pk8(X); *(u32x4*)(base + 128 + pos0) = pk8(Y); }
                } else if (pn < 12) {
                    bf16_t* base = vbuf + (size_t)row * KVP + (pn - 8) * 256 + pos0;
                    *(u32x4*)base = pk8(X); *(u32x4*)(base + 128) = pk8(Y);
                } else if (pn < 14) {
                    bf16_t* base = qi + (size_t)row * QIP + (pn - 12) * 256;
                    if (wc == 0) {
                        const f32x4* cp = (const f32x4*)(ropeI + (size_t)row * 8); float ox[8], oy[8];
#pragma unroll
                        for (int e2 = 0; e2 < 4; ++e2) { const f32x4 cs = cp[e2];
                            ox[2 * e2] = X[2 * e2] * cs[0] - Y[2 * e2] * cs[1]; oy[2 * e2] = Y[2 * e2] * cs[0] + X[2 * e2] * cs[1];
                            ox[2 * e2 + 1] = X[2 * e2 + 1] * cs[2] - Y[2 * e2 + 1] * cs[3]; oy[2 * e2 + 1] = Y[2 * e2 + 1] * cs[2] + X[2 * e2 + 1] * cs[3]; }
                        *(u32x4*)(base + fq * 64) = pk8(ox); *(u32x4*)(base + fq * 64 + 8) = pk8(oy);
                    } else { const int q0 = pos0 - 32, hh = (q0 >= 48) ? 1 : 0, d = 16 + q0 - 48 * hh;
                        *(u32x4*)(base + hh * 64 + d) = pk8(X); *(u32x4*)(base + (2 + hh) * 64 + d) = pk8(Y); }
                } else {
                    if (pos0 == 0) {
                        const f32x4* cp = (const f32x4*)(ropeI + (size_t)row * 8); float ox[8], oy[8];
#pragma unroll
                        for (int e2 = 0; e2 < 4; ++e2) { const f32x4 cs = cp[e2];
                            ox[2 * e2] = X[2 * e2] * cs[0] - Y[2 * e2] * cs[1]; oy[2 * e2] = Y[2 * e2] * cs[0] + X[2 * e2] * cs[1];
                            ox[2 * e2 + 1] = X[2 * e2 + 1] * cs[2] - Y[2 * e2 + 1] * cs[3]; oy[2 * e2 + 1] = Y[2 * e2 + 1] * cs[2] + X[2 * e2 + 1] * cs[3]; }
                        *(u32x4*)(ki + (size_t)row * 64) = pk8(ox); *(u32x4*)(ki + (size_t)row * 64 + 8) = pk8(oy);
                    } else if (pos0 < 56) { *(u32x4*)(ki + (size_t)row * 64 + 8 + pos0) = pk8(X); }
                    else if (pos0 < 80) { float* mp = misc + (size_t)row * 32 + (pos0 - 56);
                        *(f32x4*)mp = (f32x4){X[0], X[1], X[2], X[3]}; *(f32x4*)(mp + 4) = (f32x4){X[4], X[5], X[6], X[7]}; }
                }
                asm volatile("" ::: "memory");
            }
    }
};

template <bool HALF_ONLY> struct EpiMixProbe {
    static constexpr bool PERM = true, AFTER_DRAIN = false, KSCALE = false, PREP = false;
    bf16_t* dstbase;
    DI void operator()(const f32x4 (&acc)[2][2][4][2], const pg8::Unit& u, int wr, int wc, int fr, int fq) const {
        const int row0 = u.pm * 256 + wr * 64 + fr, colt = wc * 32 + 8 * fq; const int pn = u.pn;
        bf16_t* dst = dstbase + (pn % 6) * 256; const int ld = XBP;
#pragma unroll
        for (int ai = 0; ai < 2; ++ai)
#pragma unroll
            for (int m = 0; m < 4; ++m) {
                const int row = row0 + ai * 128 + m * 16;
#pragma unroll
                for (int bj = 0; bj < (HALF_ONLY ? 1 : 2); ++bj) {
                    const f32x4 a = acc[ai][bj][m][0] + acc[ai][1][m][0], b = acc[ai][bj][m][1] + acc[ai][1][m][1];
                    u32x4 w = {pk2(a[0], a[1]), pk2(a[2], a[3]), pk2(b[0], b[1]), pk2(b[2], b[3])};
                    *(u32x4*)(dst + (size_t)row * ld + bj * 128 + colt) = w;
                }
            }
    }
};
struct EpiStoreOnly {
    static constexpr bool PERM = true, AFTER_DRAIN = false, KSCALE = false, PREP = false;
    bf16_t* act;
    DI void operator()(const f32x4 (&acc)[2][2][4][2], const pg8::Unit& u, int wr, int wc, int fr, int fq) const {
        const int row0 = u.pm * 256 + wr * 64 + fr, col = u.pn * 128 + wc * 32 + 8 * fq;
#pragma unroll
        for (int ai = 0; ai < 2; ++ai)
#pragma unroll
            for (int m = 0; m < 4; ++m) {
                const int row = row0 + ai * 128 + m * 16;
                const f32x4 a = acc[ai][0][m][0] + acc[ai][1][m][0], b2 = acc[ai][0][m][1] + acc[ai][1][m][1];
                u32x4 w = {pk2(a[0], a[1]), pk2(a[2], a[3]), pk2(b2[0], b2[1]), pk2(b2[2], b2[3])};
                *(u32x4*)(act + (size_t)row * ACTP + col) = w;
            }
    }
};
struct EpiNull {
    static constexpr bool PERM = true, AFTER_DRAIN = false, KSCALE = false, PREP = false;
    float* dst;
    DI void operator()(const f32x4 (&acc)[2][2][4][2], const pg8::Unit& u, int wr, int wc, int fr, int fq) const {
        f32x4 s = {0.f, 0.f, 0.f, 0.f};
#pragma unroll
        for (int ai = 0; ai < 2; ++ai)
#pragma unroll
            for (int bj = 0; bj < 2; ++bj)
#pragma unroll
                for (int m = 0; m < 4; ++m)
#pragma unroll
                    for (int n = 0; n < 2; ++n) s += acc[ai][bj][m][n];
        *(f32x4*)(dst + ((size_t)(u.pm * 22 + u.pn) * 512 + threadIdx.x) * 4) = s;
    }
};

DI void phase_pro(const Ctx& c_in) {
    Ctx c = c_in; { int t_ = c.tid; asm volatile("" : "+v"(t_)); c.tid = t_; c.lane = t_ & 63; }
    const int gw = blockIdx.x * 8 + c.wid, nw = gridDim.x * 8;
    const float* xin = c.x(); const int* posp = c.pos();
    for (int row = gw; row < MTOK; row += nw) {
        const f32x4* src = (const f32x4*)(xin + (size_t)row * DM); float ss = 0.f;
#pragma unroll
        for (int j = 0; j < 4; ++j) {
            const f32x4 v = src[j * 64 + c.lane];
            u32x2 w = {pk2(v[0], v[1]), pk2(v[2], v[3])}; *(u32x2*)(c.hb() + (size_t)row * HBP + j * 256 + c.lane * 4) = w;
            ss += (v[0] * v[0] + v[1] * v[1]) + (v[2] * v[2] + v[3] * v[3]);
        }
#pragma unroll
        for (int o = 32; o >= 1; o >>= 1) ss += __shfl_xor(ss, o);
        if (c.lane < 16) c.ssp()[(size_t)row * 16 + c.lane] = (c.lane == 0) ? ss : 0.f;
    }
    const int gt = blockIdx.x * NTHR + c.tid, nt = gridDim.x * NTHR;
    for (int i = gt; i < MTOK * 24; i += nt) {
        const int t = i / 24, f = i % 24;
        const float ang = (float)posp[t] * *(const float __attribute__((address_space(4)))*)(karg_base() + 160 + 4 * f);
        const double rev = (double)ang * 0.15915494309189533577; const double fr = rev - __builtin_rint(rev);
        const float r = (float)fr;
        const f32x2 cs = {__builtin_amdgcn_cosf(r), __builtin_amdgcn_sinf(r)};
        if (f < 16) c.ropeA()[(size_t)t * 16 + f] = cs; else c.ropeI()[(size_t)t * 8 + (f - 16)] = cs;
    }
}

template <int MAP> DI int wmap(int n) {
    if (MAP == 0) return n;
    if (MAP == 1) { const int pn = n >> 8, bj = (n >> 7) & 1, jj = n & 127; return bj * DFF + pn * 128 + jj; }
    const int pn = n >> 8, bj = (n >> 7) & 1, pos = n & 127;
    if (pn < 8) {
        const int base = (pn < 4) ? 2576 : 3600, pp = pn & 3; int head, d;
        if (pos < 16) { head = 2 * pp; d = pos + 16 * bj; }
        else if (pos < 32) { head = 2 * pp + 1; d = (pos - 16) + 16 * bj; }
        else { head = 2 * pp + bj; d = pos; }
        return base + head * 128 + d;
    }
    if (pn < 12) return 4624 + (n - 2048);
    if (pn < 14) {
        const int hA = 4 * (pn - 12); int head, d;
        if (pos < 32) { head = hA + (pos >> 3); d = (pos & 7) + 8 * bj; }
        else { const int q = pos - 32; head = hA + 2 * bj + (q >= 48 ? 1 : 0); d = 16 + (q >= 48 ? q - 48 : q); }
        return 5648 + head * 64 + d;
    }
    if (bj == 0) {
        if (pos < 8) return 6160 + pos;
        if (pos < 56) return 6160 + 8 + pos;
        if (pos < 72) return 2560 + (pos - 56);
        if (pos < 80) return 6224 + (pos - 72);
        return -1;
    }
    return (pos < 8) ? 6168 + pos : -1;
}
template <int MAP> DI void convert_w(const Ctx& c_in, const float* W, int K, int Nsrc, bf16_t* Bt, int Nout, const float* gain, int klim, float scale) {
    Ctx c = c_in; { int t_ = c.tid; asm volatile("" : "+v"(t_)); c.tid = t_; c.lane = t_ & 63; }
    LAS float* tile = (LAS float*)c.lds;
    const int nkt = K / 64, ntiles = (Nout / 64) * nkt;
    const int n4 = (c.tid & 15) * 4, kl = c.tid >> 4;
    const int sn = c.tid >> 3, sk = (c.tid & 7) * 8;
    f32x4 r0, r1; int buf = 0;
    int t = blockIdx.x;
    if (t < ntiles) {
        const int n0 = (t / nkt) * 64, k0 = (t % nkt) * 64, src = wmap<MAP>(n0 + n4); const int srcc = src >= 0 ? src : 0;
        r0 = *(const f32x4*)(W + (size_t)(k0 + kl) * Nsrc + srcc); r1 = *(const f32x4*)(W + (size_t)(k0 + kl + 32) * Nsrc + srcc);
        if (src < 0) { r0 = (f32x4){0.f, 0.f, 0.f, 0.f}; r1 = r0; }
    }
    for (; t < ntiles; t += gridDim.x) {
        const int n0 = (t / nkt) * 64, k0 = (t % nkt) * 64;
        {
            const float g0 = ((gain != nullptr && k0 + kl < klim) ? gain[k0 + kl] : 1.f) * scale, g1 = ((gain != nullptr && k0 + kl + 32 < klim) ? gain[k0 + kl + 32] : 1.f) * scale;
            LAS float* tb = tile + buf * (64 * 65);
#pragma unroll
            for (int e = 0; e < 4; ++e) { tb[kl * 65 + n4 + e] = r0[e] * g0; tb[(kl + 32) * 65 + n4 + e] = r1[e] * g1; }
        }
        __syncthreads();
        const int t2 = t + gridDim.x;
        if (t2 < ntiles) {
            const int n02 = (t2 / nkt) * 64, k02 = (t2 % nkt) * 64, src = wmap<MAP>(n02 + n4); const int srcc = src >= 0 ? src : 0;
            r0 = *(const f32x4*)(W + (size_t)(k02 + kl) * Nsrc + srcc); r1 = *(const f32x4*)(W + (size_t)(k02 + kl + 32) * Nsrc + srcc);
            if (src < 0) { r0 = (f32x4){0.f, 0.f, 0.f, 0.f}; r1 = r0; }
        }
        {
            const LAS float* tb = tile + buf * (64 * 65);
            u32x4 w;
#pragma unroll
            for (int e = 0; e < 4; ++e) w[e] = pk2(tb[(sk + 2 * e) * 65 + sn], tb[(sk + 2 * e + 1) * 65 + sn]);
            *(u32x4*)(Bt + (size_t)(n0 + sn) * K + k0 + sk) = w;
        }
        buf ^= 1;
    }
    __syncthreads();
}


#define WRLANE(dst, sval, ln) asm volatile("s_nop 3\n\tv_writelane_b32 %0, %1, %2" : "+v"(dst) : "s"(sval), "n"(ln))
DI unsigned ord_key(float v) { const unsigned u = __float_as_uint(v); return u ^ ((u & 0x80000000u) ? 0xffffffffu : 0x80000000u); }
DI void sel_load_q(const Ctx& c, int u, int c32, int hi, bf16x8 (&af)[2][4], float (&wv)[2][4][4]) {
    const int t8 = (SEQ / 8 - 1) - (u >> 2), b = u & 3; const size_t tok0 = (size_t)b * SEQ + t8 * 8;
#pragma unroll
    for (int mt = 0; mt < 2; ++mt) {
        const size_t tq = tok0 + 4 * mt + (c32 >> 3);
#pragma unroll
        for (int ks = 0; ks < 4; ++ks) af[mt][ks] = *(const bf16x8*)(c.qi() + tq * QIP + (c32 & 7) * 64 + 16 * ks + 8 * hi);
#pragma unroll
        for (int tl = 0; tl < 4; ++tl) { const f32x4 w4 = *(const f32x4*)(c.misc() + (tok0 + 4 * mt + tl) * 32 + 16 + 4 * hi);
            wv[mt][tl][0] = w4[0]; wv[mt][tl][1] = w4[1]; wv[mt][tl][2] = w4[2]; wv[mt][tl][3] = w4[3]; }
    }
}
DI void sel_load_kgroup(const bf16_t* kbase, int kt0, int nkt, bf16x8 (&b)[4][4]) {
#pragma unroll
    for (int j = 0; j < 4; ++j) { const int kt = (kt0 + 8 * j < nkt) ? kt0 + 8 * j : nkt - 1;
#pragma unroll
        for (int ks = 0; ks < 4; ++ks) b[j][ks] = *(const bf16x8*)(kbase + (size_t)kt * 32 * 64 + 16 * ks); }
}
DI void sel_score_group(const bf16x8 (&af)[2][4], const float (&wv)[2][4][4], const bf16x8 (&b)[4][4], LAS float* sc, int kt0, int nkt, int c32, int hi) {
#pragma unroll
    for (int j = 0; j < 4; ++j) { const int kt = kt0 + 8 * j;
        if (kt < nkt) {
            const int s0 = kt * 32;
#pragma unroll
            for (int mt = 0; mt < 2; ++mt) {
                f32x16 acc = {};
#pragma unroll
                for (int ks = 0; ks < 4; ++ks) acc = MFMA32(af[mt][ks], b[j][ks], acc);
                float tot[4];
#pragma unroll
                for (int tl = 0; tl < 4; ++tl) {
                    float p = 0.f;
#pragma unroll
                    for (int jj = 0; jj < 4; ++jj) p += wv[mt][tl][jj] * fmaxf(acc[4 * tl + jj], 0.f);
                    const auto rr = __builtin_amdgcn_permlane32_swap(__float_as_uint(p), __float_as_uint(p), false, false);
                    tot[tl] = (__uint_as_float(rr[0]) + __uint_as_float(rr[1])) + 0.0f;
                }
                const int ql = 4 * mt + 2 * hi;
                sc[ql * 4096 + s0 + c32] = hi ? tot[2] : tot[0];
                sc[(ql + 1) * 4096 + s0 + c32] = hi ? tot[3] : tot[1];
            }
        } }
}
DI void sel_score_tile(const bf16x8 (&af)[2][4], const float (&wv)[2][4][4], const bf16x8 (&b)[4], LAS float* sc, int s0, int c32, int hi) {
#pragma unroll
    for (int mt = 0; mt < 2; ++mt) {
        f32x16 acc = {};
#pragma unroll
        for (int ks = 0; ks < 4; ++ks) acc = MFMA32(af[mt][ks], b[ks], acc);
        float tot[4];
#pragma unroll
        for (int tl = 0; tl < 4; ++tl) {
            float p = 0.f;
#pragma unroll
            for (int jj = 0; jj < 4; ++jj) p += wv[mt][tl][jj] * fmaxf(acc[4 * tl + jj], 0.f);
            const auto rr = __builtin_amdgcn_permlane32_swap(__float_as_uint(p), __float_as_uint(p), false, false);
            tot[tl] = (__uint_as_float(rr[0]) + __uint_as_float(rr[1])) + 0.0f;
        }
        const int ql = 4 * mt + 2 * hi;
        sc[ql * 4096 + s0 + c32] = hi ? tot[2] : tot[0];
        sc[(ql + 1) * 4096 + s0 + c32] = hi ? tot[3] : tot[1];
    }
}
DI void phase_select(const Ctx& c_in) {
    Ctx c = c_in; { int t_ = c.tid; asm volatile("" : "+v"(t_)); c.tid = t_; c.lane = t_ & 63; }
    LAS float* sc = (LAS float*)c.lds;
    const int lane = c.lane, wid = c.wid, c32 = lane & 31, hi = lane >> 5;
    bf16x8 af[2][4]; float wv[2][4][4];
    if ((int)blockIdx.x < NB * (SEQ / 8)) sel_load_q(c, blockIdx.x, c32, hi, af, wv);
    for (int u = blockIdx.x; u < NB * (SEQ / 8); u += gridDim.x) {
        const int t8 = (SEQ / 8 - 1) - (u >> 2), b = u & 3, t0 = t8 * 8;
        const int nkt = (t0 + 7) / 32 + 1;
        const bf16_t* kbase = c.ki() + ((size_t)b * SEQ + c32) * 64 + 8 * hi;
        {
            bf16x8 bcur[4], bnxt[4];
            { const int kt = (wid < nkt) ? wid : nkt - 1;
#pragma unroll
              for (int ks = 0; ks < 4; ++ks) bcur[ks] = *(const bf16x8*)(kbase + (size_t)kt * 32 * 64 + 16 * ks); }
            for (int kt = wid; kt < nkt; kt += 8) {
                { const int k2 = (kt + 8 < nkt) ? kt + 8 : nkt - 1;
#pragma unroll
                  for (int ks = 0; ks < 4; ++ks) bnxt[ks] = *(const bf16x8*)(kbase + (size_t)k2 * 32 * 64 + 16 * ks); }
                sel_score_tile(af, wv, bcur, sc, kt * 32, c32, hi);
#pragma unroll
                for (int ks = 0; ks < 4; ++ks) bcur[ks] = bnxt[ks];
            }
        }
        if (u + (int)gridDim.x < NB * (SEQ / 8)) sel_load_q(c, u + gridDim.x, c32, hi, af, wv);
        __syncthreads();
        {
            int lane_ = c.lane; asm volatile("" : "+v"(lane_)); const int lane = lane_;
            const int t = t0 + wid; unsigned mlo = 0u, mhi = 0u;
            if (t < 256) {
#pragma unroll
                for (int r = 0; r < 64; ++r) {
                    const unsigned long long bal = __ballot(r * 64 + lane <= t);
                    WRLANE(mlo, (unsigned)bal, r); WRLANE(mhi, (unsigned)(bal >> 32), r);
                    __builtin_amdgcn_sched_barrier(0);
                }
            } else {
                unsigned key[64];
                const int nreg = (t >> 6) + 1;
#pragma unroll
                for (int r = 0; r < 64; ++r) { const int s = r * 64 + lane; const float v = sc[wid * 4096 + s]; key[r] = (s <= t) ? ord_key(v) : 0u; }
#ifndef PROBE_BITS
#define PROBE_BITS 1
#endif
                unsigned T = 0u; int cge = 4096;
                for (int rep = 0; rep < PROBE_BITS; ++rep) { T = 0u;
                for (int bit = 31; bit >= 0; --bit) {
                    const unsigned cand = T | (1u << bit); int cnt = 0;
#pragma unroll
                    for (int g = 0; g < 8; ++g) {
                        if (g * 8 < nreg) {
                            { unsigned long long m0 = __ballot(key[g * 8] >= cand), m1 = __ballot(key[g * 8 + 1] >= cand), m2 = __ballot(key[g * 8 + 2] >= cand), m3 = __ballot(key[g * 8 + 3] >= cand),
                                                 m4 = __ballot(key[g * 8 + 4] >= cand), m5 = __ballot(key[g * 8 + 5] >= cand), m6 = __ballot(key[g * 8 + 6] >= cand), m7 = __ballot(key[g * 8 + 7] >= cand);
                              asm volatile("" : "+s"(m0), "+s"(m1), "+s"(m2), "+s"(m3), "+s"(m4), "+s"(m5), "+s"(m6), "+s"(m7));
                              cnt += (__popcll(m0) + __popcll(m1)) + (__popcll(m2) + __popcll(m3)) + ((__popcll(m4) + __popcll(m5)) + (__popcll(m6) + __popcll(m7))); }
                        }
                        __builtin_amdgcn_sched_barrier(0);
                    }
                    if (cnt >= 256) { T = cand; cge = cnt; if (cnt == 256) break; }
                } }
#ifndef PROBE_FINAL
#define PROBE_FINAL 1
#endif
                for (int repf = 0; repf < PROBE_FINAL; ++repf) {
                if (cge == 256) {
#pragma unroll
                    for (int g = 0; g < 8; ++g) {
                        if (g * 8 < nreg) {
#pragma unroll
                            for (int rr = 0; rr < 8; ++rr) { const unsigned long long word = __ballot(key[g * 8 + rr] >= T);
                                WRLANE(mlo, (unsigned)word, g * 8 + rr); WRLANE(mhi, (unsigned)(word >> 32), g * 8 + rr); }
                        }
                        __builtin_amdgcn_sched_barrier(0);
                    }
                } else {
                int cgt = 0;
#pragma unroll
                for (int g = 0; g < 8; ++g) {
#pragma unroll
                    for (int rr = 0; rr < 8; ++rr) cgt += __popcll(__ballot(key[g * 8 + rr] > T));
                    __builtin_amdgcn_sched_barrier(0);
                }
                int need = 256 - cgt;
#pragma unroll
                for (int r = 0; r < 64; ++r) {
                    const unsigned long long gt = __ballot(key[r] > T); unsigned long long eq = __ballot(key[r] == T), take;
                    const int ne = __popcll(eq);
                    if (ne <= need) { take = eq; need -= ne; }
                    else { take = 0ull; while (need > 0) { const unsigned long long low = eq & (0ull - eq); take |= low; eq ^= low; --need; } }
                    const unsigned long long word = gt | take;
                    WRLANE(mlo, (unsigned)word, r); WRLANE(mhi, (unsigned)(word >> 32), r);
                    __builtin_amdgcn_sched_barrier(0);
                }
                }
                }
            }
            u32x2 w = {mlo, mhi};
            *(u32x2*)(c.mask() + ((size_t)b * SEQ + t) * 128 + 2 * lane) = w;
        }
        __syncthreads();
    }
}

constexpr int VT_PITCH = 136;
#define KSW(row) ((((row) & 7) | ((((row) >> 4) & 1) << 3)) << 4)
constexpr int ATT_KBUF = 16384, ATT_VBUF = 128 * VT_PITCH, ATT_K_OFF = 0, ATT_V_OFF = 2 * ATT_KBUF;
constexpr float ATT_C2 = 0.08838834764831845f * 1.4426950408889634f, ATT_THR = 8.0f;
DI void att_S(const LAS unsigned char* Kr, const bf16x8 (&qr)[8], int c32, int hi, f32x16& p0, f32x16& p1) {
    p0 = (f32x16){}; p1 = (f32x16){};
#pragma unroll
    for (int g = 0; g < 4; ++g) {
        bf16x8 a0[2], a1[2];
#pragma unroll
        for (int dd = 0; dd < 2; ++dd) { const int ch = 2 * (2 * g + dd) + hi;
            a0[dd] = *(const LAS bf16x8*)(Kr + c32 * 256 + ((ch * 16) ^ KSW(c32)));
            a1[dd] = *(const LAS bf16x8*)(Kr + (c32 + 32) * 256 + ((ch * 16) ^ KSW(c32))); }
        __builtin_amdgcn_sched_barrier(0);
#pragma unroll
        for (int dd = 0; dd < 2; ++dd) { p0 = MFMA32(a0[dd], qr[2 * g + dd], p0); p1 = MFMA32(a1[dd], qr[2 * g + dd], p1); }
        __builtin_amdgcn_sched_barrier(0);
    }
}
DI void att_SM(f32x16& p0, f32x16& p1, u32x2 mcur, int hi, float& m_run, float& l_run, f32x16 (&o)[4], bf16x8 (&pb)[4]) {
    const float NEG = -__builtin_inff();
    const unsigned w0 = mcur[0] >> (4 * hi), w1 = mcur[1] >> (4 * hi);
    float tmax = NEG;
#pragma unroll
    for (int r = 0; r < 16; ++r) {
        const int bp = (r & 3) + 8 * (r >> 2);
        const unsigned m0 = (unsigned)__builtin_amdgcn_sbfe((int)w0, bp, 1), m1 = (unsigned)__builtin_amdgcn_sbfe((int)w1, bp, 1);
        p0[r] = __uint_as_float((__float_as_uint(p0[r]) & m0) | (0xff800000u & ~m0)); p1[r] = __uint_as_float((__float_as_uint(p1[r]) & m1) | (0xff800000u & ~m1));
        tmax = fmaxf(tmax, fmaxf(p0[r], p1[r]));
    }
    { const auto rr = __builtin_amdgcn_permlane32_swap(__float_as_uint(tmax), __float_as_uint(tmax), false, false); tmax = fmaxf(__uint_as_float(rr[0]), __uint_as_float(rr[1])); }
    if (!__all((tmax - m_run) * 0.08838834764831845f <= ATT_THR)) {
        const float mn = fmaxf(m_run, tmax); const float alpha = __builtin_amdgcn_exp2f((m_run - mn) * ATT_C2); m_run = mn;
        l_run *= alpha;
#pragma unroll
        for (int db = 0; db < 4; ++db)
#pragma unroll
            for (int r = 0; r < 16; ++r) o[db][r] *= alpha;
    }
    const float mnl = -m_run * ATT_C2; float ps = 0.f;
#pragma unroll
    for (int r = 0; r < 16; ++r) { p0[r] = __builtin_amdgcn_exp2f(fmaf(p0[r], ATT_C2, mnl)); p1[r] = __builtin_amdgcn_exp2f(fmaf(p1[r], ATT_C2, mnl)); ps += p0[r] + p1[r]; }
    l_run += ps;
    pb[0] = pack8((f32x4){p0[0], p0[1], p0[2], p0[3]}, (f32x4){p0[4], p0[5], p0[6], p0[7]});
    pb[1] = pack8((f32x4){p0[8], p0[9], p0[10], p0[11]}, (f32x4){p0[12], p0[13], p0[14], p0[15]});
    pb[2] = pack8((f32x4){p1[0], p1[1], p1[2], p1[3]}, (f32x4){p1[4], p1[5], p1[6], p1[7]});
    pb[3] = pack8((f32x4){p1[8], p1[9], p1[10], p1[11]}, (f32x4){p1[12], p1[13], p1[14], p1[15]});
}
DI void att_PV(const LAS unsigned char* Vr, const bf16x8 (&pb)[4], f32x16 (&o)[4], int c32, int hi) {
#pragma unroll
    for (int db = 0; db < 4; ++db) {
        s16x4 lo[4], hh[4];
#pragma unroll
        for (int ks = 0; ks < 4; ++ks) { const LAS unsigned char* vp = Vr + (32 * db + c32) * VT_PITCH + (16 * ks + 4 * hi) * 2;
            lo[ks] = *(const LAS s16x4*)vp; hh[ks] = *(const LAS s16x4*)(vp + 16); }
        __builtin_amdgcn_sched_barrier(0);
#pragma unroll
        for (int ks = 0; ks < 4; ++ks) { const bf16x8 a = {lo[ks][0], lo[ks][1], lo[ks][2], lo[ks][3], hh[ks][0], hh[ks][1], hh[ks][2], hh[ks][3]};
            o[db] = MFMA32(a, pb[ks], o[db]); }
        __builtin_amdgcn_sched_barrier(0);
    }
}
DI void phase_attn(const Ctx& c_in, const int dummy) {
    Ctx c = c_in; { int t_ = c.tid; asm volatile("" : "+v"(t_)); c.tid = t_; c.lane = t_ & 63; }
    LAS unsigned char* Kl = c.lds + ATT_K_OFF; LAS unsigned char* Vl = c.lds + ATT_V_OFF;
    const int lane = c.lane, wid = c.wid, tid = c.tid, c32 = lane & 31, hi = lane >> 5;
    for (int u = blockIdx.x; u < NB * 8 * 8; u += gridDim.x) {
        const int x = u & 7, hd = (u >> 3) & 7, b = u >> 6;
        for (int half = 0; half < 2; ++half) {
            const int qb = half ? 15 - x : x, P0 = qb * 256; const size_t tq = (size_t)b * SEQ + P0 + 32 * wid + c32;
            bf16_t* qptr = c.ymix() + tq * YP + 1024 + hd * 128;
            bf16x8 qr[8];
#pragma unroll
            for (int d0 = 0; d0 < 8; ++d0) qr[d0] = *(const bf16x8*)(qptr + 16 * d0 + 8 * hi);
            float m_run = -1e30f, l_run = 0.f; f32x16 o[4] = {};
            const int ntiles = P0 / 64 + 4;
            const bf16_t* kbase = c.kbuf() + (size_t)b * SEQ * KVP + hd * 128; const bf16_t* vbase = c.vbuf() + (size_t)b * SEQ * KVP + hd * 128;
            const unsigned* mrow = c.mask() + tq * 128;
            bf16x8 sk0, sk1, sv0, sv1;
#define ATT_LOAD(jt) do { const size_t k0_ = (size_t)(jt) * 64; \
                sk0 = *(const bf16x8*)(kbase + (k0_ + (tid >> 4)) * KVP + (tid & 15) * 8); sk1 = *(const bf16x8*)(kbase + (k0_ + 32 + (tid >> 4)) * KVP + (tid & 15) * 8); \
                sv0 = *(const bf16x8*)(vbase + (k0_ + lane) * KVP + 16 * wid); sv1 = *(const bf16x8*)(vbase + (k0_ + lane) * KVP + 16 * wid + 8); } while (0)
#define ATT_WRITE(kb, vb) do { LAS unsigned char* Kw = Kl + (kb) * ATT_KBUF; LAS unsigned char* Vw = Vl + (vb) * ATT_VBUF; const int key_ = tid >> 4, ch_ = tid & 15; \
                *(LAS bf16x8*)(Kw + key_ * 256 + ((ch_ * 16) ^ KSW(key_))) = sk0; *(LAS bf16x8*)(Kw + (key_ + 32) * 256 + ((ch_ * 16) ^ KSW(key_))) = sk1; \
                _Pragma("unroll") for (int e = 0; e < 8; ++e) { *(LAS short*)(Vw + (16 * wid + e) * VT_PITCH + lane * 2) = sv0[e]; *(LAS short*)(Vw + (16 * wid + 8 + e) * VT_PITCH + lane * 2) = sv1[e]; } } while (0)
            __syncthreads();
            ATT_LOAD(0); ATT_WRITE(0, 0);
            if (ntiles > 1) ATT_LOAD(1);
            u32x2 mw = *(const u32x2*)(mrow);
            __syncthreads();
            bf16x8 pb[4] = {}; int vprev = 0, vcur = 0;
            for (int j = 0; j < ntiles; ++j) {
                const int kb = j & 1; int vnext = vcur + 1; if (vnext == 3) vnext = 0;
                if (j + 1 < ntiles) ATT_WRITE(kb ^ 1, vnext);
                if (j + 2 < ntiles) ATT_LOAD(j + 2);
                const u32x2 mcur = mw;
                if (j + 1 < ntiles) mw = *(const u32x2*)(mrow + 2 * (j + 1));
                const LAS unsigned char* Kr = Kl + kb * ATT_KBUF;
                f32x16 p0, p1;
                att_S(Kr, qr, c32, hi, p0, p1);
                att_PV(Vl + vprev * ATT_VBUF, pb, o, c32, hi);
                att_SM(p0, p1, mcur, hi, m_run, l_run, o, pb);
                vprev = vcur; vcur = vnext;
                __syncthreads();
            }
            att_PV(Vl + vprev * ATT_VBUF, pb, o, c32, hi);
#undef ATT_LOAD
#undef ATT_WRITE
            l_run += __shfl_xor(l_run, 32);
            const float rl = 1.0f / l_run;
#pragma unroll
            for (int db = 0; db < 4; ++db)
#pragma unroll
                for (int g = 0; g < 4; ++g) {
                    u32x2 w = {pk2(o[db][4 * g] * rl, o[db][4 * g + 1] * rl), pk2(o[db][4 * g + 2] * rl, o[db][4 * g + 3] * rl)};
                    *(u32x2*)((dummy ? qptr - 1024 : qptr) + 32 * db + 8 * g + 4 * hi) = w;
                }
        }
    }
}

template <int NT> DI void conv_seg(const bf16_t* xbc, size_t tok_first, int pos_first, int cidx, const float* cw, const float* cb, float (&out)[NT][8]) {
    u32x4 rows[NT + 3];
#pragma unroll
    for (int i = 0; i < NT + 3; ++i) {
        const int off = i - 3, offc = (off < -pos_first) ? -pos_first : off;
        const u32x4 v = *(const u32x4*)(xbc + (size_t)((long)tok_first + offc) * XBP + cidx);
        const bool ok = (pos_first + off >= 0);
        rows[i] = (u32x4){ok ? v[0] : 0u, ok ? v[1] : 0u, ok ? v[2] : 0u, ok ? v[3] : 0u};
    }
    float w[4][8], bias[8];
#pragma unroll
    for (int k = 0; k < 4; ++k) { const f32x4 w0 = *(const f32x4*)(cw + k * XBCW + cidx), w1 = *(const f32x4*)(cw + k * XBCW + cidx + 4);
        w[k][0] = w0[0]; w[k][1] = w0[1]; w[k][2] = w0[2]; w[k][3] = w0[3]; w[k][4] = w1[0]; w[k][5] = w1[1]; w[k][6] = w1[2]; w[k][7] = w1[3]; }
    { const f32x4 b0 = *(const f32x4*)(cb + cidx), b1 = *(const f32x4*)(cb + cidx + 4);
      bias[0] = b0[0]; bias[1] = b0[1]; bias[2] = b0[2]; bias[3] = b0[3]; bias[4] = b1[0]; bias[5] = b1[1]; bias[6] = b1[2]; bias[7] = b1[3]; }
#pragma unroll
    for (int j = 0; j < NT; ++j)
#pragma unroll
        for (int e = 0; e < 8; ++e) {
            float a = bias[e];
#pragma unroll
            for (int k = 0; k < 4; ++k) { const unsigned wd = rows[j + k][e >> 1]; a += w[k][e] * ((e & 1) ? bfhi(wd) : bflo(wd)); }
            out[j][e] = silu_f(a);
        }
}
constexpr int SSD_PITCH = 264;
DI void ssd_dt_scan(const Ctx& c, LAS float* dtl, LAS float* acs, size_t tok0, int h, const float* dt_bias, const float* a_log) {
    if (c.tid < 256) {
        const float v = c.misc()[(tok0 + c.tid) * 32 + h] + dt_bias[h];
        const float sp = fmaxf(v, 0.f) + log1pf(__expf(-fabsf(v)));
        dtl[c.tid] = sp;
    }
    __syncthreads();
    if (c.wid == 0) {
        const float a = -__expf(a_log[h]);
        const float a0 = dtl[4 * c.lane] * a, a1 = dtl[4 * c.lane + 1] * a, a2 = dtl[4 * c.lane + 2] * a, a3 = dtl[4 * c.lane + 3] * a;
        const float s1 = a0, s2 = s1 + a1, s3 = s2 + a2, s4 = s3 + a3; float tot = s4;
#pragma unroll
        for (int off = 1; off < 64; off <<= 1) { const float n = __shfl_up(tot, off); if (c.lane >= off) tot += n; }
        const float base = tot - s4;
        acs[4 * c.lane] = base + s1; acs[4 * c.lane + 1] = base + s2; acs[4 * c.lane + 2] = base + s3; acs[4 * c.lane + 3] = base + s4;
    }
    __syncthreads();
}
DI void phase_ssd_states(const Ctx& c_in, const float* cw, const float* cb, const float* dt_bias, const float* a_log) {
    Ctx c = c_in; { int t_ = c.tid; asm volatile("" : "+v"(t_)); c.tid = t_; c.lane = t_ & 63; }
    LAS bf16_t* XT = (LAS bf16_t*)c.lds;
    LAS bf16_t* BT = (LAS bf16_t*)(c.lds + 64 * SSD_PITCH * 2);
    LAS float* dtl = (LAS float*)(c.lds + 192 * SSD_PITCH * 2); LAS float* acs = dtl + 256;
    const int lane = c.lane, wid = c.wid, tid = c.tid, c32 = lane & 31, hi = lane >> 5;
    for (int u = blockIdx.x; u < 1024; u += gridDim.x) {
        const int h = u & 15, ch = (u >> 4) & 15, b = u >> 8, g = h >> 3; const size_t tok0 = (size_t)b * SEQ + ch * 256;
        ssd_dt_scan(c, dtl, acs, tok0, h, dt_bias, a_log);
        const float alast = acs[255];
        {
            const int oct = tid & 7, l0 = (tid >> 3) * 4; float v[4][8];
            conv_seg<4>(c.xbc(), tok0 + l0, ch * 256 + l0, h * 64 + oct * 8, cw, cb, v);
            float sc[4];
#pragma unroll
            for (int j = 0; j < 4; ++j) sc[j] = dtl[l0 + j] * __expf(alast - acs[l0 + j]);
#pragma unroll
            for (int e = 0; e < 8; ++e) { u32x2 w = {pk2(v[0][e] * sc[0], v[1][e] * sc[1]), pk2(v[2][e] * sc[2], v[3][e] * sc[3])}; *(LAS u32x2*)(XT + (oct * 8 + e) * SSD_PITCH + l0) = w; }
        }
        {
            const int oct = tid & 15, l0 = (tid >> 4) * 8; float v[8][8];
            conv_seg<8>(c.xbc(), tok0 + l0, ch * 256 + l0, 1024 + g * 128 + oct * 8, cw, cb, v);
#pragma unroll
            for (int e = 0; e < 8; ++e) { u32x4 w = {pk2(v[0][e], v[1][e]), pk2(v[2][e], v[3][e]), pk2(v[4][e], v[5][e]), pk2(v[6][e], v[7][e])}; *(LAS u32x4*)(BT + (oct * 8 + e) * SSD_PITCH + l0) = w; }
        }
        __syncthreads();
        const int pb = wid >> 2, nb = wid & 3; f32x16 acc = {};
#pragma unroll
        for (int ks = 0; ks < 16; ++ks) {
            const bf16x8 a = *(const LAS bf16x8*)(XT + (32 * pb + c32) * SSD_PITCH + 16 * ks + 8 * hi);
            const bf16x8 bb = *(const LAS bf16x8*)(BT + (32 * nb + c32) * SSD_PITCH + 16 * ks + 8 * hi);
            acc = MFMA32(a, bb, acc);
        }
        float* st = c.states() + (size_t)u * 8192;
#pragma unroll
        for (int r = 0; r < 16; ++r) st[(32 * pb + crow(r, hi)) * 128 + 32 * nb + c32] = acc[r];
        if (tid == 0) c.cdec()[u] = __expf(alast);
        __syncthreads();
    }
}
DI void phase_ssd_out(const Ctx& c_in, const float* cw, const float* cb, const float* dt_bias, const float* a_log, const float* d_skip, const int dummy) {
    Ctx c = c_in; { int t_ = c.tid; asm volatile("" : "+v"(t_)); c.tid = t_; c.lane = t_ & 63; }
    LAS unsigned char* Bn = c.lds;
    LAS bf16_t* XT = (LAS bf16_t*)(c.lds + 65536);
    LAS bf16_t* Hs = (LAS bf16_t*)(c.lds + 65536 + 64 * SSD_PITCH * 2);
    LAS float* dtl = (LAS float*)(c.lds + 65536 + 64 * SSD_PITCH * 2 + 64 * 136 * 2); LAS float* acs = dtl + 256;
    const int wid = c.wid;
    for (int u = blockIdx.x; u < 1024; u += gridDim.x) {
        int tid_ = c.tid; asm volatile("" : "+v"(tid_)); const int tid = tid_, lane = tid & 63, c32 = lane & 31, hi = lane >> 5;
        const int h = u & 15, ch = (u >> 4) & 15, b = u >> 8, g = h >> 3; const size_t tok0 = (size_t)b * SEQ + ch * 256;
        ssd_dt_scan(c, dtl, acs, tok0, h, dt_bias, a_log);
        {
            const int oct = tid & 15;
#pragma unroll 1
            for (int hf = 0; hf < 2; ++hf) { const int l0 = (tid >> 4) * 8 + 4 * hf; float v[4][8];
                conv_seg<4>(c.xbc(), tok0 + l0, ch * 256 + l0, 1280 + g * 128 + oct * 8, cw, cb, v);
#pragma unroll
                for (int j = 0; j < 4; ++j) { const int l = l0 + j;
                    *(LAS bf16x8*)(Bn + l * 256 + ((oct * 16) ^ ((l & 7) << 4))) = pack8((f32x4){v[j][0], v[j][1], v[j][2], v[j][3]}, (f32x4){v[j][4], v[j][5], v[j][6], v[j][7]}); } }
        }
        {
            const int oct = tid & 7, l0 = (tid >> 3) * 4; float v[4][8];
            conv_seg<4>(c.xbc(), tok0 + l0, ch * 256 + l0, h * 64 + oct * 8, cw, cb, v);
#pragma unroll
            for (int e = 0; e < 8; ++e) { u32x2 w = {pk2(v[0][e], v[1][e]), pk2(v[2][e], v[3][e])}; *(LAS u32x2*)(XT + (oct * 8 + e) * SSD_PITCH + l0) = w; }
        }
        {
            const int p = tid >> 3, n0 = (tid & 7) * 16; f32x4 hs[4] = {};
            for (int cc = 0; cc < ch; ++cc) {
                const int u2 = ((b * 16 + cc) << 4) + h; const float* sp = c.states() + (size_t)u2 * 8192 + p * 128 + n0; const float dec = c.cdec()[u2];
#pragma unroll
                for (int q = 0; q < 4; ++q) hs[q] = hs[q] * dec + *(const f32x4*)(sp + 4 * q);
            }
            *(LAS bf16x8*)(Hs + p * 136 + n0) = pack8(hs[0], hs[1]); *(LAS bf16x8*)(Hs + p * 136 + n0 + 8) = pack8(hs[2], hs[3]);
        }
        __syncthreads();
        const int l = 32 * wid + c32; bf16x8 qr[8];
#pragma unroll
        for (int ks = 0; ks < 8; ++ks) qr[ks] = *(const LAS bf16x8*)(Bn + l * 256 + (((2 * ks + hi) * 16) ^ ((l & 7) << 4)));
        __syncthreads();
        {
            const int oct = tid & 15;
#pragma unroll 1
            for (int hf = 0; hf < 2; ++hf) { const int l0 = (tid >> 4) * 8 + 4 * hf; float v[4][8];
                conv_seg<4>(c.xbc(), tok0 + l0, ch * 256 + l0, 1024 + g * 128 + oct * 8, cw, cb, v);
#pragma unroll
                for (int j = 0; j < 4; ++j) { const int l2 = l0 + j;
                    *(LAS bf16x8*)(Bn + l2 * 256 + ((oct * 16) ^ ((l2 & 7) << 4))) = pack8((f32x4){v[j][0], v[j][1], v[j][2], v[j][3]}, (f32x4){v[j][4], v[j][5], v[j][6], v[j][7]}); } }
        }
        __syncthreads();
        const float acs_l = acs[l], dsk = d_skip[h];
        f32x16 o[2] = {};
        for (int j = 0; j <= wid; ++j) {
            f32x16 p = {};
#pragma unroll
            for (int ks = 0; ks < 8; ++ks) {
                const int row = 32 * j + c32, chn = 2 * ks + hi;
                const bf16x8 a = *(const LAS bf16x8*)(Bn + row * 256 + ((chn * 16) ^ ((row & 7) << 4)));
                p = MFMA32(a, qr[ks], p);
            }
#pragma unroll
            for (int r = 0; r < 16; ++r) {
                const int s = 32 * j + crow(r, hi);
                float v = p[r] * __expf(acs_l - acs[s]) * dtl[s];
                v = (s <= l) ? v : 0.f;
                p[r] = (s == l) ? v + dsk : v;
            }
            bf16x8 pb[2];
            pb[0] = pack8((f32x4){p[0], p[1], p[2], p[3]}, (f32x4){p[4], p[5], p[6], p[7]});
            pb[1] = pack8((f32x4){p[8], p[9], p[10], p[11]}, (f32x4){p[12], p[13], p[14], p[15]});
#pragma unroll
            for (int pk = 0; pk < 2; ++pk)
#pragma unroll
                for (int ks = 0; ks < 2; ++ks) {
                    const LAS bf16_t* xp = XT + (32 * pk + c32) * SSD_PITCH + 32 * j + 16 * ks + 4 * hi;
                    const s16x4 lo = *(const LAS s16x4*)xp, hh = *(const LAS s16x4*)(xp + 8);
                    const bf16x8 a = {lo[0], lo[1], lo[2], lo[3], hh[0], hh[1], hh[2], hh[3]};
                    o[pk] = MFMA32(a, pb[ks], o[pk]);
                }
        }
        {
            f32x16 o2[2] = {};
#pragma unroll
            for (int pk = 0; pk < 2; ++pk)
#pragma unroll
                for (int ks = 0; ks < 8; ++ks) {
                    const bf16x8 a = *(const LAS bf16x8*)(Hs + (32 * pk + c32) * 136 + 16 * ks + 8 * hi);
                    o2[pk] = MFMA32(a, qr[ks], o2[pk]);
                }
            const float el = __expf(acs_l);
#pragma unroll
            for (int pk = 0; pk < 2; ++pk)
#pragma unroll
                for (int r = 0; r < 16; ++r) o[pk][r] += el * o2[pk][r];
        }
        bf16_t* zrow = c.ymix() + (tok0 + l) * YP + h * 64; float ss = 0.f;
#pragma unroll
        for (int pk = 0; pk < 2; ++pk)
#pragma unroll
            for (int gq = 0; gq < 4; ++gq) {
                bf16_t* zp = zrow + 32 * pk + 8 * gq + 4 * hi; const u32x2 zz = *(const u32x2*)zp;
                const float y0 = o[pk][4 * gq] * silu_f(bflo(zz[0])), y1 = o[pk][4 * gq + 1] * silu_f(bfhi(zz[0]));
                const float y2 = o[pk][4 * gq + 2] * silu_f(bflo(zz[1])), y3 = o[pk][4 * gq + 3] * silu_f(bfhi(zz[1]));
                u32x2 w = {pk2(y0, y1), pk2(y2, y3)};
                const float r0 = bflo(w[0]), r1 = bfhi(w[0]), r2 = bflo(w[1]), r3 = bfhi(w[1]);
                ss += (r0 * r0 + r1 * r1) + (r2 * r2 + r3 * r3);
                *(u32x2*)(dummy ? c.hb() + (tok0 + l) * HBP + h * 64 + 32 * pk + 8 * gq + 4 * hi : zp) = w;
            }
        ss += __shfl_xor(ss, 32);
        if (hi == 0) c.ssq()[(tok0 + l) * 16 + h] = ss;
        __syncthreads();
    }
}
DI void phase_final(const Ctx& c_in, const float* gain) {
    Ctx c = c_in; { int t_ = c.tid; asm volatile("" : "+v"(t_)); c.tid = t_; c.lane = t_ & 63; }
    const int gt = blockIdx.x * NTHR + c.tid, nt = gridDim.x * NTHR; float* hout = c.h();
    for (int i = gt; i < MTOK * 256; i += nt) {
        const int row = i >> 8, c4 = (i & 255) * 4; const float rs = row_rstd(c.ssp(), row);
        f32x4* p = (f32x4*)(hout + (size_t)row * DM + c4); const f32x4 g = *(const f32x4*)(gain + c4);
        *p = *p * rs * g;
    }
}

constexpr int PH_PER_LAYER = 12, N_PHASES = 2 + 2 * PH_PER_LAYER;
#ifndef PH_MASK
#define PH_MASK 0xffffffffu
#endif
#define KIND(q) (((PH_MASK) >> (q)) & 1u)
#define IN(k) (lo <= (k) && (k) < hi)
DI Ctx launder_ctx(const Ctx& c0) { Ctx c = c0; size_t z = 0; asm volatile("" : "+s"(z)); c.ws = c0.ws + z; return c; }
#define LC() launder_ctx(c0)
DI XcdBarrier make_bar(const Ctx& c0) { XcdBarrier b; size_t z = 0; asm volatile("" : "+s"(z)); unsigned char* w = c0.ws + z; b.bar = (unsigned*)(w + WS_CTL); b.x = xb_xcc_id(); b.st = (volatile LAS unsigned*)(c0.lds + LDS_BAR_OFF); return b; }
#define SEAM(k) do { if (IN(k) && IN((k) + 1)) xcd_barrier(make_bar(c0)); } while (0)
#ifndef PROBE_WC
#define PROBE_WC 1
#endif
#ifndef PROBE_FFNIN
#define PROBE_FFNIN 1
#endif
#ifndef PROBE_D1
#define PROBE_D1 1
#endif
#ifndef PROBE_SEL
#define PROBE_SEL 1
#endif
#ifndef PROBE_ATTN
#define PROBE_ATTN 0
#endif
#ifndef PROBE_S0
#define PROBE_S0 1
#endif
#ifndef PROBE_S1
#define PROBE_S1 1
#endif
#ifndef PROBE_S3
#define PROBE_S3 0
#endif
template <int layer> DI void layer_phases(const Ctx& c0, const int lo, const int hi) {
    const int G = (int)gridDim.x, bx = (int)blockIdx.x;
    constexpr int pb = 1 + layer * PH_PER_LAYER;
#define LP(i, stride) (argp(i) + (size_t)layer * (stride))
    if (KIND(1) && IN(pb + 0)) for (int rep = 0; rep < PROBE_WC; ++rep) {
        const Ctx c = LC();
        convert_w<1>(LC(), LP(3, (size_t)DM * NFFIN), DM, NFFIN, c.wb() + WB_1IN, NFFIN, LP(2, DM), DM, 1.0f);
        convert_w<0>(LC(), LP(4, (size_t)DFF * DM), DFF, DM, c.wb() + WB_1OUT, DM, nullptr, 0, 0.5f);
        convert_w<2>(LC(), LP(6, (size_t)DM * DINPROJ), DM, DINPROJ, c.wb() + WB_MIXB, NMIXB, LP(5, DM), DM, 1.0f);
        convert_w<0>(LC(), LP(6, (size_t)DM * DINPROJ), DM, DINPROJ, c.wb() + WB_MIXA, NMIXA, LP(5, DM), DM, 1.0f);
        convert_w<0>(LC(), LP(13, (size_t)2048 * DM), 2048, DM, c.wb() + WB_MO, DM, LP(12, DM), DM, 1.0f);
        convert_w<1>(LC(), LP(15, (size_t)DM * NFFIN), DM, NFFIN, c.wb() + WB_2IN, NFFIN, LP(14, DM), DM, 1.0f);
        convert_w<0>(LC(), LP(16, (size_t)DFF * DM), DFF, DM, c.wb() + WB_2OUT, DM, nullptr, 0, 0.5f);
    }
    SEAM(pb + 0);
#if PROBE_FFNIN > 1
    if (KIND(2) && IN(pb + 1)) {
        const Ctx c = LC(); pg8::Gemm g{c.hb(), c.wb() + WB_1IN, MTOK, NFFIN, DM, HBP}; pg8::StaticOrder S; S.init(MTOK, NFFIN, G, bx);
#if PROBE_FFNIN == 3
        EpiNull E{(float*)c.ymix()};
        pg8::gemm_phase<EpiNull, pg8::StaticOrder, false>(c.lds, g, S, E, nullptr);
#elif PROBE_FFNIN == 4
        EpiStoreOnly E{c.act()};
        pg8::gemm_phase<EpiStoreOnly, pg8::StaticOrder, false>(c.lds, g, S, E, nullptr);
#else
        EpiSwiGLU E{c.act(), c.ssp(), (LAS float*)(c.lds + RS_LDS_OFF)};
        pg8::gemm_phase<EpiSwiGLU, pg8::StaticOrder, false>(c.lds, g, S, E, nullptr);
#endif
    }
#endif
    if (KIND(2) && IN(pb + 1)) {
        const Ctx c = LC(); pg8::Gemm g{c.hb(), c.wb() + WB_1IN, MTOK, NFFIN, DM, HBP}; pg8::StaticOrder S; S.init(MTOK, NFFIN, G, bx);
        EpiSwiGLU E{c.act(), c.ssp(), (LAS float*)(c.lds + RS_LDS_OFF)};
        pg8::gemm_phase<EpiSwiGLU, pg8::StaticOrder, false>(c.lds, g, S, E, nullptr);
    }
    SEAM(pb + 1);
    if (KIND(3) && IN(pb + 2)) {
        const Ctx c = LC(); pg8::Gemm g{c.act(), c.wb() + WB_1OUT, MTOK, DM, DFF, ACTP}; pg8::StaticOrder S; S.init(MTOK, DM, G, bx);
#ifdef PROBE_RES
        { EpiResid E0{layer == 0 ? c.x() : c.h(), (float*)c.ymix(), c.hb(), c.ssp(), nullptr, 1}; pg8::gemm_phase<EpiResid, pg8::StaticOrder, false>(c.lds, g, S, E0, nullptr); }
#endif
        EpiResid E{layer == 0 ? c.x() : c.h(), c.h(), c.hb(), c.ssp(), nullptr, 0};
        pg8::gemm_phase<EpiResid, pg8::StaticOrder, false>(c.lds, g, S, E, nullptr);
    }
    SEAM(pb + 2);
    if (KIND(4) && IN(pb + 3)) for (int rep = 0; rep < PROBE_D1; ++rep) {
        const Ctx c = LC(); pg8::Gemm g{c.hb(), c.wb() + WB_MIXB, MTOK, NMIXB, DM, HBP}; pg8::StaticOrder S; S.init(MTOK, NMIXB, G, bx);
        EpiMixB E{c.ssp(), c.ymix(), c.kbuf(), c.vbuf(), c.qi(), c.ki(), c.misc(), c.ropeA(), c.ropeI(), (LAS float*)(c.lds + RS_LDS_OFF)};
        pg8::gemm_phase<EpiMixB, pg8::StaticOrder, false>(c.lds, g, S, E, nullptr);
    }
    SEAM(pb + 3);
    if (KIND(6) && IN(pb + 4)) for (int rep = 0; rep < PROBE_SEL; ++rep) phase_select(LC());
    SEAM(pb + 4);
    if (KIND(7) && IN(pb + 5)) { if (PROBE_ATTN) phase_attn(LC(), 1); phase_attn(LC(), 0); }
    SEAM(pb + 5);
#ifdef PROBE_S0NULL
    if (KIND(5) && IN(pb + 6)) {
        const Ctx c = LC(); pg8::Gemm g{c.hb(), c.wb() + WB_MIXA, MTOK, NMIXA, DM, HBP}; pg8::StaticOrder S; S.init(MTOK, NMIXA, G, bx);
#if PROBE_S0NULL == 1
        EpiNull E{(float*)c.act() + 8 * 1024 * 1024};
        pg8::gemm_phase<EpiNull, pg8::StaticOrder, false>(c.lds, g, S, E, nullptr);
#elif PROBE_S0NULL == 4
        EpiMixA E{c.ssp(), c.ymix(), c.xbc(), (LAS float*)(c.lds + RS_LDS_OFF)};
        pg8::gemm_phase<EpiMixA, pg8::StaticOrder, false>(c.lds, g, S, E, nullptr);
#elif PROBE_S0NULL == 5
        EpiMixAT<false> E{c.ssp(), c.ymix(), c.xbc(), (LAS float*)(c.lds + RS_LDS_OFF)};
        pg8::gemm_phase<EpiMixAT<false>, pg8::StaticOrder, false>(c.lds, g, S, E, nullptr);
#elif PROBE_S0NULL == 2
        EpiMixProbe<false> E{c.xbc()};
        pg8::gemm_phase<EpiMixProbe<false>, pg8::StaticOrder, false>(c.lds, g, S, E, nullptr);
#else
        EpiMixProbe<true> E{c.xbc()};
        pg8::gemm_phase<EpiMixProbe<true>, pg8::StaticOrder, false>(c.lds, g, S, E, nullptr);
#endif
    }
#endif
    if (KIND(5) && IN(pb + 6)) for (int rep = 0; rep < PROBE_S0; ++rep) {
        const Ctx c = LC(); pg8::Gemm g{c.hb(), c.wb() + WB_MIXA, MTOK, NMIXA, DM, HBP}; pg8::StaticOrder S; S.init(MTOK, NMIXA, G, bx);
        EpiMixA E{c.ssp(), c.ymix(), c.xbc(), (LAS float*)(c.lds + RS_LDS_OFF)};
        pg8::gemm_phase<EpiMixA, pg8::StaticOrder, false>(c.lds, g, S, E, nullptr);
    }
    SEAM(pb + 6);
    if (KIND(8) && IN(pb + 7)) for (int rep = 0; rep < PROBE_S1; ++rep) phase_ssd_states(LC(), LP(7, 4 * XBCW), LP(8, XBCW), LP(9, 16), LP(10, 16));
    SEAM(pb + 7);
    if (KIND(10) && IN(pb + 8)) { if (PROBE_S3) phase_ssd_out(LC(), LP(7, 4 * XBCW), LP(8, XBCW), LP(9, 16), LP(10, 16), LP(11, 16), 1); phase_ssd_out(LC(), LP(7, 4 * XBCW), LP(8, XBCW), LP(9, 16), LP(10, 16), LP(11, 16), 0); }
    SEAM(pb + 8);
    if (KIND(9) && IN(pb + 9)) {
        const Ctx c = LC(); pg8::Gemm g{c.ymix(), c.wb() + WB_MO, MTOK, DM, 2048, YP}; pg8::StaticOrder S; S.init(MTOK, DM, G, bx);
        EpiResidKS E{c.h(), c.h(), c.hb(), c.ssp(), c.ssq(), 0};
        pg8::gemm_phase<EpiResidKS, pg8::StaticOrder, false>(c.lds, g, S, E, nullptr);
    }
    SEAM(pb + 9);
    if (KIND(2) && IN(pb + 10)) {
        const Ctx c = LC(); pg8::Gemm g{c.hb(), c.wb() + WB_2IN, MTOK, NFFIN, DM, HBP}; pg8::StaticOrder S; S.init(MTOK, NFFIN, G, bx);
        EpiSwiGLU E{c.act(), c.ssp(), (LAS float*)(c.lds + RS_LDS_OFF)};
        pg8::gemm_phase<EpiSwiGLU, pg8::StaticOrder, false>(c.lds, g, S, E, nullptr);
    }
    SEAM(pb + 10);
    if (KIND(3) && IN(pb + 11)) {
        const Ctx c = LC(); pg8::Gemm g{c.act(), c.wb() + WB_2OUT, MTOK, DM, DFF, ACTP}; pg8::StaticOrder S; S.init(MTOK, DM, G, bx);
#ifdef PROBE_RES
        { EpiResid E0{c.h(), (float*)c.ymix(), c.hb(), c.ssp(), nullptr, 1}; pg8::gemm_phase<EpiResid, pg8::StaticOrder, false>(c.lds, g, S, E0, nullptr); }
#endif
        EpiResid E{c.h(), c.h(), c.hb(), c.ssp(), nullptr, 0};
        pg8::gemm_phase<EpiResid, pg8::StaticOrder, false>(c.lds, g, S, E, nullptr);
    }
    SEAM(pb + 11);
}
__global__ void __launch_bounds__(NTHR, 2) mk_fwd(Args args) {
    extern __shared__ __attribute__((aligned(16))) unsigned char lds_raw[];
    Ctx c;
    c.lds = (LAS unsigned char*)lds_raw; c.tid = threadIdx.x; c.lane = c.tid & 63; c.wid = __builtin_amdgcn_readfirstlane(c.tid >> 6);
    unsigned char* ws = args.ws; c.ws = ws;
    const int lo = args.ph_lo, hi = args.ph_hi;
    const bool multi = (hi - lo) > 1;
    if (c.tid == 0) *(LAS u32x4*)(c.lds + LDS_BAR_OFF) = (u32x4){0u, 0u, 0u, 0u};
    __syncthreads();
    if (multi) (void)xcd_barrier_post((unsigned*)(ws + WS_CTL), (volatile LAS unsigned*)(c.lds + LDS_BAR_OFF));
    const Ctx& c0 = c;

    if (KIND(0) && IN(0)) { phase_pro(LC()); } SEAM(0);
#ifdef PROBE_BAR
    if (multi) for (int rep = 0; rep < PROBE_BAR; ++rep) xcd_barrier(make_bar(c0));
#endif
    layer_phases<0>(c0, lo, hi);
    layer_phases<1>(c0, lo, hi);


    if (KIND(12) && IN(N_PHASES - 1)) phase_final(LC(), argp(17));
#undef IN
#undef SEAM
}

#ifndef MK_N_LAUNCHES
#define MK_N_LAUNCHES 1
#endif
extern "C" void kernel_launch(void* const* d_in, const int* in_sizes, int n_in, void* d_out, int out_size, void* d_ws, size_t ws_size, hipStream_t stream) {
    static int grid = 0;
    if (grid == 0) {
        if (n_in != 18 || out_size != MTOK * DM || ws_size < WS_END) { fprintf(stderr, "kernel_launch: unexpected shapes (n_in %d out %d ws %zu need %zu)\n", n_in, out_size, ws_size, (size_t)WS_END); grid = -1; return; }
        int dev = 0, cus = 0, per_cu = 0;
        if (hipGetDevice(&dev) != hipSuccess || hipDeviceGetAttribute(&cus, hipDeviceAttributeMultiprocessorCount, dev) != hipSuccess) { grid = -1; return; }
        if (hipFuncSetAttribute((const void*)mk_fwd, hipFuncAttributeMaxDynamicSharedMemorySize, LDS_BYTES) != hipSuccess) { fprintf(stderr, "kernel_launch: hipFuncSetAttribute failed\n"); grid = -1; return; }
        if (hipOccupancyMaxActiveBlocksPerMultiprocessor(&per_cu, (const void*)mk_fwd, NTHR, LDS_BYTES) != hipSuccess || per_cu < 1) fprintf(stderr, "kernel_launch: occupancy query says %d\n", per_cu);
        (void)hipGetLastError();
        grid = cus;
    }
    if (grid < 0) return;
    (void)hipMemsetAsync((char*)d_ws + WS_CTL, 0, 64 * 1024, stream);
    Args a{};
    for (int i = 0; i < 18; ++i) a.in[i] = (const float*)d_in[i];
    a.out = (float*)d_out; a.ws = (unsigned char*)d_ws;
    for (int f = 0; f < 16; ++f) a.invf[f] = (float)pow(500000.0, -(double)(2 * f) / 32.0);
    for (int f = 0; f < 8; ++f) a.invf[16 + f] = (float)pow(500000.0, -(double)(2 * f) / 16.0);
    if (MK_N_LAUNCHES == 1) {
        a.ph_lo = 0; a.ph_hi = N_PHASES;
        hipLaunchKernelGGL(mk_fwd, dim3(grid), dim3(NTHR), LDS_BYTES, stream, a);
    } else {
        for (int p = 0; p < N_PHASES; ++p) { a.ph_lo = p; a.ph_hi = p + 1; hipLaunchKernelGGL(mk_fwd, dim3(grid), dim3(NTHR), LDS_BYTES, stream, a); }
    }
}
```

```cpp
#include <hip/hip_runtime.h>
#include <cstdio>
#include <cstdint>
#include <cmath>

#define DI __device__ __forceinline__
#define LAS __attribute__((address_space(3)))
typedef unsigned short bf16_t;
typedef short bf16x8 __attribute__((ext_vector_type(8)));
typedef short s16x4 __attribute__((ext_vector_type(4)));
typedef float f32x2 __attribute__((ext_vector_type(2)));
typedef float f32x4 __attribute__((ext_vector_type(4)));
typedef float f32x16 __attribute__((ext_vector_type(16)));
typedef unsigned u32x2 __attribute__((ext_vector_type(2)));
typedef unsigned u32x4 __attribute__((ext_vector_type(4)));
typedef __bf16 bf2_t __attribute__((ext_vector_type(2)));

DI unsigned pk2(float a, float b) { bf2_t v = __builtin_convertvector((f32x2){a, b}, bf2_t); return __builtin_bit_cast(unsigned, v); }
DI bf16_t f2bf(float a) { return (bf16_t)(pk2(a, 0.f) & 0xffffu); }
DI float bf2f(bf16_t v) { return __uint_as_float(((unsigned)v) << 16); }
DI float bflo(unsigned w) { return __uint_as_float(w << 16); }
DI float bfhi(unsigned w) { return __uint_as_float(w & 0xffff0000u); }
DI bf16x8 pack8(f32x4 a, f32x4 b) { u32x4 w = {pk2(a[0], a[1]), pk2(a[2], a[3]), pk2(b[0], b[1]), pk2(b[2], b[3])}; return __builtin_bit_cast(bf16x8, w); }
DI float silu_f(float x) { return x * __builtin_amdgcn_rcpf(1.0f + __builtin_amdgcn_exp2f(-1.4426950408889634f * x)); }
DI int crow(int r, int hi) { return (r & 3) + 8 * (r >> 2) + 4 * hi; }
#define MFMA32(a, b, c) __builtin_amdgcn_mfma_f32_32x32x16_bf16((a), (b), (c), 0, 0, 0)

constexpr int NB = 4, SEQ = 4096, MTOK = NB * SEQ, DM = 1024, DFF = 2816, NFFIN = 2 * DFF;
constexpr int NMIXB = 3840, NMIXA = 2560, DINPROJ = 6232, XBCW = 1536;
constexpr int NTHR = 512;
constexpr int HBP = DM + 64, YP = 2048 + 64, KVP = 1024 + 64, QIP = 512 + 64, XBP = XBCW + 64, ACTP = DFF + 64;
constexpr float EPS = 1e-6f;
constexpr int LDS_BYTES = 147456;
constexpr int LDS_BAR_OFF = LDS_BYTES - 16;

constexpr size_t KiB = 1024, MiB = 1024 * 1024;
constexpr size_t WS_CTL = 0;
constexpr size_t WS_SSP = 64 * KiB;
constexpr size_t WS_ROPEA = WS_SSP + 1 * MiB;
constexpr size_t WS_ROPEI = WS_ROPEA + 2 * MiB;
constexpr size_t WS_SSQ = WS_ROPEI + 1 * MiB;
constexpr size_t WS_CDEC = WS_SSQ + 1 * MiB;
constexpr size_t WS_WB = WS_CDEC + 64 * KiB;
constexpr size_t WS_HB = WS_WB + 50 * MiB;
constexpr size_t WS_YMIX = WS_HB + 34 * MiB;
constexpr size_t WS_MISC = WS_YMIX + 66 * MiB;
constexpr size_t WS_R = WS_MISC + 2 * MiB;
constexpr size_t WS_END = WS_R + 96 * MiB;
static_assert(WS_END <= 256 * MiB, "workspace");
constexpr size_t R_K = 0, R_V = 34 * MiB, R_QI = 68 * MiB, R_KI = 86 * MiB, R_MASK = 88 * MiB;
constexpr size_t R_XBC = 0, R_STATES = 50 * MiB;
constexpr size_t R_ACT = 0;
constexpr size_t WB_1IN = 0, WB_1OUT = WB_1IN + (size_t)NFFIN * DM, WB_MIXB = WB_1OUT + (size_t)DM * DFF, WB_MIXA = WB_MIXB + (size_t)NMIXB * DM,
                 WB_MO = WB_MIXA + (size_t)NMIXA * DM, WB_2IN = WB_MO + (size_t)DM * 2048, WB_2OUT = WB_2IN + (size_t)NFFIN * DM, WB_END = WB_2OUT + (size_t)DM * DFF;
static_assert(WB_END * 2 <= 50 * MiB, "weights");

struct Args { const float* in[18]; float* out; unsigned char* ws; float invf[24]; int ph_lo, ph_hi; };

typedef const __attribute__((address_space(4))) unsigned char* kargp_t;
DI kargp_t karg_base() { kargp_t ka = (kargp_t)__builtin_amdgcn_kernarg_segment_ptr(); asm volatile("" : "+s"(ka)); return ka; }
#define GLOBAL_AS __attribute__((address_space(1)))
template <class T> DI T* as_global(T* p) { return (T*)(GLOBAL_AS T*)p; }
DI const float* argp(int i) { return *(const float* const __attribute__((address_space(4)))*)(karg_base() + 8 * i); }
struct Ctx {
    LAS unsigned char* lds; int tid, lane, wid; unsigned char* ws;
    DI const float* x() const { return argp(0); }
    DI const int* pos() const { return (const int*)argp(1); }
    DI float* h() const { return (float*)argp(18); }
    DI float* ssp() const { return (float*)(ws + WS_SSP); }
    DI f32x2* ropeA() const { return (f32x2*)(ws + WS_ROPEA); }
    DI f32x2* ropeI() const { return (f32x2*)(ws + WS_ROPEI); }
    DI float* ssq() const { return (float*)(ws + WS_SSQ); }
    DI float* cdec() const { return (float*)(ws + WS_CDEC); }
    DI bf16_t* wb() const { return (bf16_t*)(ws + WS_WB); }
    DI bf16_t* hb() const { return (bf16_t*)(ws + WS_HB); }
    DI bf16_t* ymix() const { return (bf16_t*)(ws + WS_YMIX); }
    DI float* misc() const { return (float*)(ws + WS_MISC); }
    DI bf16_t* kbuf() const { return (bf16_t*)(ws + WS_R + R_K); }
    DI bf16_t* vbuf() const { return (bf16_t*)(ws + WS_R + R_V); }
    DI bf16_t* qi() const { return (bf16_t*)(ws + WS_R + R_QI); }
    DI bf16_t* ki() const { return (bf16_t*)(ws + WS_R + R_KI); }
    DI unsigned* mask() const { return (unsigned*)(ws + WS_R + R_MASK); }
    DI bf16_t* xbc() const { return (bf16_t*)(ws + WS_R + R_XBC); }
    DI float* states() const { return (float*)(ws + WS_R + R_STATES); }
    DI bf16_t* act() const { return (bf16_t*)(ws + WS_R + R_ACT); }
};

DI float row_rstd(const float* ssp, int row) {
    const f32x4* p = (const f32x4*)(ssp + (size_t)row * 16);
    const f32x4 a = p[0], b = p[1], c = p[2], d = p[3];
    const float s = ((a[0] + a[1]) + (a[2] + a[3])) + ((b[0] + b[1]) + (b[2] + b[3])) + ((c[0] + c[1]) + (c[2] + c[3])) + ((d[0] + d[1]) + (d[2] + d[3]));
    return rsqrtf(s * (1.0f / 1024.0f) + EPS);
}
namespace pg8 {
#define PG8_LAS __attribute__((address_space(3)))
typedef unsigned short bf16_t;
typedef short bf16x8 __attribute__((ext_vector_type(8)));
typedef float f32x4 __attribute__((ext_vector_type(4)));
typedef unsigned u32x4 __attribute__((ext_vector_type(4)));
constexpr int BM = 256, BK = 64, HALF = 128, HTB = HALF * BK * 2  , STAGE_BYTES = 8 * HTB, NXCD = 8, WGM = 8;

__host__ __device__ __forceinline__ int lds_byte(int r, int c) { const int st = (r >> 4) * 2 + (c >> 5), rr = r & 15, cc = c & 31, ob = rr * 64 + cc * 2; return st * 1024 + (ob ^ (((ob >> 9) & 1) << 5)); }
__host__ __device__ __forceinline__ void stage_rc(int b, int& R, int& C) { const int st = b / 1024, sb = b % 1024, swz = sb ^ (((sb >> 9) & 1) << 5); R = (st >> 1) * 16 + swz / 64; C = (st & 1) * 32 + (swz % 64) / 2; }
__host__ __device__ __forceinline__ int perm32(int rho) { const int n = rho >> 4, i = rho & 15; return 8 * (i >> 2) + 4 * n + (i & 3); }

struct Unit { int pm, pn; };
struct Gemm { const bf16_t* A; const bf16_t* Bt; int M, N, K, lda; };

struct StaticOrder {
    int nM, nN, nwg, G, c;
    __host__ __device__ void init(int M, int N, int G_, int c_) { nM = M / BM; nN = N / BM; nwg = nM * nN; G = G_; c = c_; }
    __host__ __device__ bool next(int i, Unit& u) const {
        const long L = (long)i * G + c; if (L >= nwg) return false;
        int wgid = (int)L; { const int q = nwg / NXCD, r = nwg % NXCD, xcd = wgid % NXCD, off = wgid / NXCD; wgid = (xcd < r ? xcd * (q + 1) : r * (q + 1) + (xcd - r) * q) + off; }
        const int nig = WGM * nN, gid = wgid / nig, fm = gid * WGM, gsz = (nM - fm) < WGM ? (nM - fm) : WGM;
        u.pm = fm + ((wgid % nig) % gsz); u.pn = (wgid % nig) / gsz; return true;
    }
    __device__ __forceinline__ void a_ready(const Unit&) const {}
    __device__ __forceinline__ void done(const Unit&) const {}
};
template <class Epi, class Sched, bool STAMP = false>
__device__ __forceinline__ void gemm_phase(PG8_LAS unsigned char* lds, const Gemm g, const Sched& S, const Epi& E, unsigned long long* stamps) {
    int tid_ = threadIdx.x; asm volatile("" : "+v"(tid_));
    const int tid = tid_, wid = __builtin_amdgcn_readfirstlane(tid >> 6), lane = tid & 63, wr = wid >> 2, wc = wid & 3, fr = lane & 15, fq = lane >> 4;
    const int K = g.K, nt = K / BK, lda = g.lda;
    int ts_lo = 0, ts_hi = 0, nts = 0; const unsigned long long rt_entry = STAMP ? (unsigned long long)wall_clock64() : 0ull;
#define PG8_STAMP() do { if (STAMP && wid == 0 && nts < 64) { const unsigned long long _c = (unsigned long long)clock64(); \
        ts_lo = (lane == nts) ? (int)(unsigned)_c : ts_lo; ts_hi = (lane == nts) ? (int)(unsigned)(_c >> 32) : ts_hi; ++nts; } } while (0)
    PG8_STAMP();
    unsigned voffA[2], voffB[2];
#pragma unroll
    for (int i = 0; i < 2; ++i) { int R, C; stage_rc(tid * 16 + i * 8192, R, C); const int Rb = Epi::PERM ? ((R & ~31) + perm32(R & 31)) : R;
        voffA[i] = (unsigned)(R * lda + C) * 2u; voffB[i] = (unsigned)(Rb * K + C) * 2u; }
    const size_t kstep = (size_t)(BK * 2);
    const size_t hstepA = (size_t)HALF * lda * 2, tstepA = 2 * hstepA;
    const size_t hstep = (size_t)HALF * K * 2;
    const size_t tstep = 2 * hstep;
    const unsigned ldsw = (unsigned)wid * 1024u;
    const int aoff = lds_byte(wr * 64 + fr, fq * 8), boff = lds_byte(wc * 32 + fr, fq * 8);
#define PG8_SA(b, h) (((b) * 2 + (h)) * HTB)
#define PG8_SB(b, h) ((4 + (b) * 2 + (h)) * HTB)
#define PG8_STAGE(bufoff, gbase, voff) do { _Pragma("unroll") for (int _i = 0; _i < 2; ++_i) \
        __builtin_amdgcn_global_load_lds((const unsigned*)((const char*)(gbase) + (voff)[_i]), (PG8_LAS unsigned*)(lds + (bufoff) + ldsw + _i * 8192), 16, 0, 0); } while (0)
#define PG8_LDA(dst, b, h) do { _Pragma("unroll") for (int m = 0; m < 4; ++m) _Pragma("unroll") for (int k = 0; k < 2; ++k) dst[m][k] = *(const PG8_LAS bf16x8*)(lds + PG8_SA(b, h) + aoff + m * 2048 + k * 1024); } while (0)
#define PG8_LDB(dst, b, h) do { _Pragma("unroll") for (int n = 0; n < 2; ++n) _Pragma("unroll") for (int k = 0; k < 2; ++k) dst[n][k] = *(const PG8_LAS bf16x8*)(lds + PG8_SB(b, h) + boff + n * 2048 + k * 1024); } while (0)
#define PG8_MMA(ai, bj, At, Bt) do { __builtin_amdgcn_s_setprio(1); _Pragma("unroll") for (int m = 0; m < 4; ++m) _Pragma("unroll") for (int n = 0; n < 2; ++n) _Pragma("unroll") for (int k = 0; k < 2; ++k) \
        acc[ai][bj][m][n] = __builtin_amdgcn_mfma_f32_16x16x32_bf16(Bt[n][k], At[m][k], acc[ai][bj][m][n], 0, 0, 0); __builtin_amdgcn_s_setprio(0); } while (0)
#define PG8_WAIT_V(n) asm volatile("s_waitcnt vmcnt(" #n ")" ::: "memory")
#define PG8_WAIT_L(n) asm volatile("s_waitcnt lgkmcnt(" #n ")" ::: "memory")
#define PG8_BAR __builtin_amdgcn_s_barrier()
#define PG8_SCHED __builtin_amdgcn_sched_barrier(0)
    Unit cur, nxt; int ui = 0; f32x4 pr0 = {0.f, 0.f, 0.f, 0.f}, pr1 = pr0;
    if (!S.next(0, cur)) return;
    f32x4 acc[2][2][4][2];
#pragma unroll
    for (int a = 0; a < 2; ++a)
#pragma unroll
        for (int b = 0; b < 2; ++b)
#pragma unroll
            for (int m = 0; m < 4; ++m)
#pragma unroll
                for (int n = 0; n < 2; ++n) acc[a][b][m][n] = (f32x4){0.f, 0.f, 0.f, 0.f};
    bf16x8 At[4][2], B0[2][2], B1[2][2];
    const char* cA = (const char*)g.A + (size_t)cur.pm * tstepA; const char* cB = (const char*)g.Bt + (size_t)cur.pn * tstep;
    S.a_ready(cur);
    if constexpr (Epi::PREP) E.prep(cur, 0, tid);
    PG8_STAGE(PG8_SB(0, 0), cB, voffB); PG8_STAGE(PG8_SA(0, 0), cA, voffA); PG8_STAGE(PG8_SB(0, 1), cB + hstep, voffB); PG8_STAGE(PG8_SA(0, 1), cA + hstepA, voffA);
    if (wr == 1) PG8_BAR;
    PG8_WAIT_V(4); PG8_BAR;
    PG8_STAGE(PG8_SB(1, 0), cB + kstep, voffB); PG8_STAGE(PG8_SA(1, 0), cA + kstep, voffA); PG8_STAGE(PG8_SB(1, 1), cB + hstep + kstep, voffB);
    PG8_WAIT_V(6); PG8_BAR;
    PG8_STAMP();
    for (;;) {
        const bool has_next = S.next(ui + 1, nxt);
        const char* nA = has_next ? (const char*)g.A + (size_t)nxt.pm * tstepA : cA; const char* nB = has_next ? (const char*)g.Bt + (size_t)nxt.pn * tstep : cB;
        for (int t = 0; t < nt; t += 2) {
            if constexpr (Epi::KSCALE) { if (t == 8 || t == 16) E.kscale(acc, cur, t, wr, fr); }
            const bool last = (t == nt - 2);
            const char* a1 = cA + (size_t)(t + 1) * kstep;
            const char* a2 = last ? nA : cA + (size_t)(t + 2) * kstep; const char* b2 = last ? nB : cB + (size_t)(t + 2) * kstep;
            const char* a3 = a2 + kstep; const char* b3 = b2 + kstep;
            if (last && has_next) { S.a_ready(nxt); if constexpr (Epi::PREP) E.prep_issue(nxt, tid, pr0, pr1); }
            PG8_LDB(B0, 0, 0); PG8_SCHED; PG8_LDA(At, 0, 0); PG8_STAGE(PG8_SA(1, 1), a1 + hstepA, voffA);
            PG8_WAIT_L(8); PG8_BAR; PG8_WAIT_L(0); PG8_MMA(0, 0, At, B0); PG8_BAR; PG8_SCHED;
            PG8_LDB(B1, 0, 1); PG8_STAGE(PG8_SB(0, 0), b2, voffB);
            PG8_BAR; PG8_WAIT_L(0); PG8_MMA(0, 1, At, B1); PG8_BAR;
            PG8_LDA(At, 0, 1); PG8_STAGE(PG8_SA(0, 0), a2, voffA);
            PG8_BAR; PG8_WAIT_L(0); PG8_MMA(1, 0, At, B0); PG8_BAR; PG8_SCHED;
            PG8_STAGE(PG8_SB(0, 1), b2 + hstep, voffB);
            PG8_WAIT_V(6); PG8_BAR; PG8_MMA(1, 1, At, B1); PG8_BAR;
            PG8_LDB(B0, 1, 0); PG8_SCHED; PG8_LDA(At, 1, 0); PG8_STAGE(PG8_SA(0, 1), a2 + hstepA, voffA);
            PG8_WAIT_L(8); PG8_BAR; PG8_WAIT_L(0); PG8_MMA(0, 0, At, B0); PG8_BAR; PG8_SCHED;
            PG8_LDB(B1, 1, 1); PG8_STAGE(PG8_SB(1, 0), b3, voffB);
            PG8_BAR; PG8_WAIT_L(0); PG8_MMA(0, 1, At, B1); PG8_BAR;
            PG8_LDA(At, 1, 1); PG8_STAGE(PG8_SA(1, 0), a3, voffA);
            PG8_BAR; PG8_WAIT_L(0); PG8_MMA(1, 0, At, B0); PG8_BAR; PG8_SCHED;
            PG8_STAGE(PG8_SB(1, 1), b3 + hstep, voffB);
            PG8_WAIT_V(6); PG8_BAR; PG8_MMA(1, 1, At, B1); PG8_BAR;
        }
        PG8_STAMP();
        if constexpr (Epi::PREP) { if (has_next) E.prep_finish((ui + 1) & 1, tid, pr0, pr1); }
        if constexpr (!Epi::AFTER_DRAIN) { if constexpr (Epi::PREP) E(acc, cur, wr, wc, fr, fq, ui & 1); else E(acc, cur, wr, wc, fr, fq); S.done(cur); }
        PG8_STAMP();
        if (!has_next) break;
#pragma unroll
        for (int a = 0; a < 2; ++a)
#pragma unroll
            for (int b = 0; b < 2; ++b)
#pragma unroll
                for (int m = 0; m < 4; ++m)
#pragma unroll
                    for (int n = 0; n < 2; ++n) acc[a][b][m][n] = (f32x4){0.f, 0.f, 0.f, 0.f};
        cur = nxt; cA = nA; cB = nB; ++ui;
    }
    PG8_WAIT_V(0);
    if (wr == 0) PG8_BAR;
    PG8_BAR;
    if constexpr (Epi::AFTER_DRAIN) { E.fused(acc, cur, wr, wc, fr, fq, lds, wid, lane); S.done(cur); }
    PG8_STAMP();
    if (STAMP && wid == 0) { stamps[lane] = lane < nts ? (((unsigned long long)(unsigned)ts_hi << 32) | (unsigned)ts_lo) : 0ull;
        if (lane == 62) stamps[62] = rt_entry; if (lane == 63) stamps[63] = (unsigned long long)wall_clock64(); }
#undef PG8_STAMP
#undef PG8_SA
#undef PG8_SB
#undef PG8_STAGE
#undef PG8_LDA
#undef PG8_LDB
#undef PG8_MMA
#undef PG8_WAIT_V
#undef PG8_WAIT_L
#undef PG8_BAR
#undef PG8_SCHED
}
}
#define XB_TMO      128
#define XB_XCNT(j)  (256  + 64 * (j))
#define XB_XSUB(j)  (1280 + 64 * (j))
#define XB_XGEN(j)  (2304 + 64 * (j))
#define XB_TOP      3328
#define XB_TOPGEN   3392
#define XCD_BAR_WORDS 3456
#define XB_SPIN_CAP (1u << 18)
#define LAS __attribute__((address_space(3)))

__device__ __forceinline__ unsigned xb_ld(unsigned* p)              { return __hip_atomic_load(p, __ATOMIC_RELAXED, __HIP_MEMORY_SCOPE_AGENT); }
__device__ __forceinline__ unsigned xb_add(unsigned* p, unsigned v) { return __hip_atomic_fetch_add(p, v, __ATOMIC_RELAXED, __HIP_MEMORY_SCOPE_AGENT); }
__device__ __forceinline__ unsigned xb_xcc_id() { return (unsigned)__builtin_amdgcn_s_getreg((3 << 11) | 20) & 0xFu; }
#define XB_SPIN(cond, bar) do { unsigned _sp = 0; while (cond) { __builtin_amdgcn_s_sleep(1); \
    if ((++_sp & 255u) == 0u) { if (xb_ld(&(bar)[XB_TMO])) break; if (_sp > XB_SPIN_CAP) { atomicAdd(&(bar)[XB_TMO], 1u); break; } } } } while (0)

struct XcdBarrier {
    unsigned* bar; unsigned x;
    volatile LAS unsigned* st;
};

__device__ __forceinline__ XcdBarrier xcd_barrier_post(unsigned* bar, volatile LAS unsigned* st) {
    XcdBarrier b; b.bar = bar; b.x = xb_xcc_id(); b.st = st;
    if (threadIdx.x == 0) (void)xb_add(&bar[XB_XCNT(b.x)], 1u);
    return b;
}
__device__ __forceinline__ void xcd_barrier_complete(unsigned* bar, unsigned x, unsigned& nloc, unsigned& nx) {
    const unsigned G = gridDim.x * gridDim.y * gridDim.z;
    unsigned sum, cnt, mine, sp = 0u;
    for (;;) {
        sum = 0u; cnt = 0u; mine = 0u;
#pragma unroll
        for (unsigned j = 0; j < 16; ++j) { const unsigned c = xb_ld(&bar[XB_XCNT(j)]); sum += c; cnt += (c > 0u) ? 1u : 0u; mine = (j == x) ? c : mine; }
        if (sum == G) break;
        __builtin_amdgcn_s_sleep(1);
        if ((++sp & 255u) == 0u) { if (xb_ld(&bar[XB_TMO])) break; if (sp > XB_SPIN_CAP) { atomicAdd(&bar[XB_TMO], 1u); break; } }
    }
    nloc = mine > 0u ? mine : 1u; nx = cnt > 0u ? cnt : 1u;
}

__device__ __forceinline__ void xcd_barrier(const XcdBarrier& b) {
    asm volatile("s_waitcnt vmcnt(0)" ::: "memory");
    __syncthreads();
    if (threadIdx.x == 0) {
        unsigned* bar = b.bar;
        __builtin_amdgcn_s_waitcnt(0);
        unsigned nloc = b.st[0], nx = b.st[1];
        if (nloc == 0u) { xcd_barrier_complete(bar, b.x, nloc, nx); b.st[0] = nloc; b.st[1] = nx; }
        const unsigned old = xb_add(&bar[XB_XSUB(b.x)], 1u);
        const unsigned gen = old / nloc;
        if (old + 1u == (gen + 1u) * nloc) {
            __builtin_amdgcn_fence(__ATOMIC_RELEASE, "agent");
            asm volatile("s_waitcnt vmcnt(0)" ::: "memory");
            const unsigned og = xb_add(&bar[XB_TOP], 1u);
            const unsigned tg = og / nx;
            if (og + 1u == (tg + 1u) * nx) xb_add(&bar[XB_TOPGEN], 1u);
            else XB_SPIN(xb_ld(&bar[XB_TOPGEN]) == tg, bar);
            __builtin_amdgcn_fence(__ATOMIC_ACQUIRE, "agent");
            xb_add(&bar[XB_XGEN(b.x)], 1u);
            asm volatile("s_waitcnt vmcnt(0)" ::: "memory");
        } else {
            XB_SPIN(xb_ld(&bar[XB_XGEN(b.x)]) == gen, bar);
            __builtin_amdgcn_fence(__ATOMIC_ACQUIRE, "agent");
            asm volatile("s_waitcnt vmcnt(0)" ::: "memory");
        }
    }
    __syncthreads();
}

constexpr int RS_LDS_OFF = 131072;
DI void prep_rstd(const float* ssp, LAS float* tab, int pm, int par, int tid) {
    const int row = tid >> 1, hf = tid & 1;
    const f32x4* p = (const f32x4*)(ssp + (size_t)(pm * 256 + row) * 16 + hf * 8);
    const f32x4 a = p[0], b = p[1];
    float s = ((a[0] + a[1]) + (a[2] + a[3])) + ((b[0] + b[1]) + (b[2] + b[3]));
    s += __shfl_xor(s, 1);
    if (hf == 0) tab[par * 256 + row] = rsqrtf(s * (1.0f / 1024.0f) + EPS);
}
DI void prep_rstd_issue(const float* ssp, int pm, int tid, f32x4& a, f32x4& b) {
    const int row = tid >> 1, hf = tid & 1; const f32x4* p = (const f32x4*)(ssp + (size_t)(pm * 256 + row) * 16 + hf * 8); a = p[0]; b = p[1];
}
DI void prep_rstd_finish(LAS float* tab, int par, int tid, const f32x4& a, const f32x4& b) {
    const int row = tid >> 1, hf = tid & 1;
    float s = ((a[0] + a[1]) + (a[2] + a[3])) + ((b[0] + b[1]) + (b[2] + b[3]));
    s += __shfl_xor(s, 1);
    if (hf == 0) tab[par * 256 + row] = rsqrtf(s * (1.0f / 1024.0f) + EPS);
}
struct EpiSwiGLU {
    static constexpr bool PERM = true, AFTER_DRAIN = false, KSCALE = false, PREP = true;
    bf16_t* act; const float* ssp; LAS float* tab;
    DI void prep(const pg8::Unit& u, int par, int tid) const { prep_rstd(ssp, tab, u.pm, par, tid); }
    DI void prep_issue(const pg8::Unit& u, int tid, f32x4& a, f32x4& b) const { prep_rstd_issue(ssp, u.pm, tid, a, b); }
    DI void prep_finish(int par, int tid, const f32x4& a, const f32x4& b) const { prep_rstd_finish(tab, par, tid, a, b); }
    DI void operator()(const f32x4 (&acc)[2][2][4][2], const pg8::Unit& u, int wr, int wc, int fr, int fq, int par) const {
        const int row0 = u.pm * 256 + wr * 64 + fr, col = u.pn * 128 + wc * 32 + 8 * fq;
#pragma unroll
        for (int ai = 0; ai < 2; ++ai)
#pragma unroll
            for (int m = 0; m < 4; ++m) {
                const int row = row0 + ai * 128 + m * 16; const float rs = tab[par * 256 + ai * 128 + wr * 64 + m * 16 + fr];
                float o[8];
#pragma unroll
                for (int n = 0; n < 2; ++n)
#pragma unroll
                    for (int e = 0; e < 4; ++e) o[n * 4 + e] = silu_f(acc[ai][0][m][n][e] * rs) * (acc[ai][1][m][n][e] * rs);
                u32x4 w = {pk2(o[0], o[1]), pk2(o[2], o[3]), pk2(o[4], o[5]), pk2(o[6], o[7])};
                *(u32x4*)(act + (size_t)row * ACTP + col) = w;
                asm volatile("" ::: "memory");
            }
    }
};
template <bool KS> struct EpiResidT {
    static constexpr bool PERM = false, AFTER_DRAIN = false, KSCALE = KS, PREP = false;
    const float* hin; float* hout; bf16_t* hb; float* ssp; const float* ssq; int dummy;
    DI void kscale(f32x4 (&acc)[2][2][4][2], const pg8::Unit& u, int t, int wr, int fr) const {
        int fr_ = fr; asm volatile("" : "+v"(fr_));
        const int row0 = u.pm * 256 + wr * 64 + fr_;
#pragma unroll
        for (int ai = 0; ai < 2; ++ai)
#pragma unroll
            for (int m = 0; m < 4; ++m) {
                const f32x4* sp = (const f32x4*)(ssq + (size_t)(row0 + ai * 128 + m * 16) * 16);
                const f32x4 a = sp[0], b = sp[1], c = sp[2], d = sp[3];
                const float v0 = ((a[0] + a[1]) + (a[2] + a[3]) + (b[0] + b[1]) + (b[2] + b[3])) * (1.0f / 512.0f) + EPS;
                const float v1 = ((c[0] + c[1]) + (c[2] + c[3]) + (d[0] + d[1]) + (d[2] + d[3])) * (1.0f / 512.0f) + EPS;
                const float f = (t == 8) ? rsqrtf(v0) * sqrtf(v1) : rsqrtf(v1);
#pragma unroll
                for (int bj = 0; bj < 2; ++bj)
#pragma unroll
                    for (int n = 0; n < 2; ++n) acc[ai][bj][m][n] *= f;
                asm volatile("" ::: "memory");
            }
    }
    DI void operator()(const f32x4 (&acc)[2][2][4][2], const pg8::Unit& u, int wr, int wc, int fr, int fq) const {
        const int row0 = u.pm * 256 + wr * 64 + fr, col0 = u.pn * 256 + wc * 32 + 4 * fq;
#pragma unroll
        for (int ai = 0; ai < 2; ++ai)
#pragma unroll
            for (int m = 0; m < 4; ++m) {
                const int row = row0 + ai * 128 + m * 16; float ss = 0.f;
#pragma unroll
                for (int bj = 0; bj < 2; ++bj)
#pragma unroll
                    for (int n = 0; n < 2; ++n) {
                        const size_t off = (size_t)row * DM + col0 + bj * 128 + n * 16;
                        f32x4 hv = *(const f32x4*)(hin + off); hv += acc[ai][bj][m][n];
                        *(f32x4*)(hout + off) = hv;
                        u32x2 w = {pk2(hv[0], hv[1]), pk2(hv[2], hv[3])}; if (!dummy) *(u32x2*)(hb + (size_t)row * HBP + col0 + bj * 128 + n * 16) = w;
                        ss += (hv[0] * hv[0] + hv[1] * hv[1]) + (hv[2] * hv[2] + hv[3] * hv[3]);
                    }
                ss += __shfl_xor(ss, 16); ss += __shfl_xor(ss, 32);
                if (fq == 0 && !dummy) ssp[(size_t)row * 16 + u.pn * 4 + wc] = ss;
                asm volatile("" ::: "memory");
            }
    }
};
typedef EpiResidT<false> EpiResid;
typedef EpiResidT<true> EpiResidKS;
template <bool USE_PREP> struct EpiMixAT {
    static constexpr bool PERM = true, AFTER_DRAIN = false, KSCALE = false, PREP = USE_PREP;
    const float* ssp; bf16_t* ymix; bf16_t* xbc; LAS float* tab;
    DI void prep(const pg8::Unit& u, int par, int tid) const { prep_rstd(ssp, tab, u.pm, par, tid); }
    DI void prep_issue(const pg8::Unit& u, int tid, f32x4& a, f32x4& b) const { prep_rstd_issue(ssp, u.pm, tid, a, b); }
    DI void prep_finish(int par, int tid, const f32x4& a, const f32x4& b) const { prep_rstd_finish(tab, par, tid, a, b); }
    DI void operator()(const f32x4 (&acc)[2][2][4][2], const pg8::Unit& u, int wr, int wc, int fr, int fq) const { (*this)(acc, u, wr, wc, fr, fq, 0); }
    DI void operator()(const f32x4 (&acc)[2][2][4][2], const pg8::Unit& u, int wr, int wc, int fr, int fq, int par) const {
        const int row0 = u.pm * 256 + wr * 64 + fr, colt = wc * 32 + 8 * fq; const int pn = u.pn;
        bf16_t* dst; int ld;
        if (pn < 4) { dst = ymix + pn * 256; ld = YP; } else { dst = xbc + (pn - 4) * 256; ld = XBP; }
#pragma unroll
        for (int ai = 0; ai < 2; ++ai)
#pragma unroll
            for (int m = 0; m < 4; ++m) {
                const int row = row0 + ai * 128 + m * 16; const float rs = USE_PREP ? tab[par * 256 + ai * 128 + wr * 64 + m * 16 + fr] : 1.0f;
#pragma unroll
                for (int bj = 0; bj < 2; ++bj) {
                    const f32x4 a = acc[ai][bj][m][0] * rs, b = acc[ai][bj][m][1] * rs;
                    u32x4 w = {pk2(a[0], a[1]), pk2(a[2], a[3]), pk2(b[0], b[1]), pk2(b[2], b[3])};
                    *(u32x4*)(dst + (size_t)row * ld + bj * 128 + colt) = w;
                }
                asm volatile("" ::: "memory");
            }
    }
};
typedef EpiMixAT<true> EpiMixA;
DI u32x4 pk8(const float (&v)[8]) { u32x4 w = {pk2(v[0], v[1]), pk2(v[2], v[3]), pk2(v[4], v[5]), pk2(v[6], v[7])}; return w; }
struct EpiMixB {
    static constexpr bool PERM = true, AFTER_DRAIN = false, KSCALE = false, PREP = true;
    const float* ssp; bf16_t* ymix; bf16_t* kbuf; bf16_t* vbuf; bf16_t* qi; bf16_t* ki; float* misc; const f32x2* ropeA; const f32x2* ropeI; LAS float* tab;
    DI void prep(const pg8::Unit& u, int par, int tid) const { prep_rstd(ssp, tab, u.pm, par, tid); }
    DI void prep_issue(const pg8::Unit& u, int tid, f32x4& a, f32x4& b) const { prep_rstd_issue(ssp, u.pm, tid, a, b); }
    DI void prep_finish(int par, int tid, const f32x4& a, const f32x4& b) const { prep_rstd_finish(tab, par, tid, a, b); }
    DI void operator()(const f32x4 (&acc)[2][2][4][2], const pg8::Unit& u, int wr, int wc, int fr, int fq, int par) const {
        const int row0 = u.pm * 256 + wr * 64 + fr, pos0 = wc * 32 + 8 * fq; const int pn = u.pn;
#pragma unroll
        for (int ai = 0; ai < 2; ++ai)
#pragma unroll
            for (int m = 0; m < 4; ++m) {
                const int row = row0 + ai * 128 + m * 16; const float rs = tab[par * 256 + ai * 128 + wr * 64 + m * 16 + fr];
                float X[8], Y[8];
#pragma unroll
                for (int e = 0; e < 4; ++e) { X[e] = acc[ai][0][m][0][e] * rs; X[4 + e] = acc[ai][0][m][1][e] * rs; Y[e] = acc[ai][1][m][0][e] * rs; Y[4 + e] = acc[ai][1][m][1][e] * rs; }
                if (pn < 8) {
                    bf16_t* base = (pn < 4) ? ymix + (size_t)row * YP + 1024 + pn * 256 : kbuf + (size_t)row * KVP + (pn - 4) * 256;
                    if (wc == 0) {
                        const int f0 = (8 * fq) & 15; const f32x4* cp = (const f32x4*)(ropeA + (size_t)row * 16 + f0);
                        float ox[8], oy[8];
#pragma unroll
                        for (int e2 = 0; e2 < 4; ++e2) { const f32x4 cs = cp[e2];
                            ox[2 * e2] = X[2 * e2] * cs[0] - Y[2 * e2] * cs[1]; oy[2 * e2] = Y[2 * e2] * cs[0] + X[2 * e2] * cs[1];
                            ox[2 * e2 + 1] = X[2 * e2 + 1] * cs[2] - Y[2 * e2 + 1] * cs[3]; oy[2 * e2 + 1] = Y[2 * e2 + 1] * cs[2] + X[2 * e2 + 1] * cs[3]; }
                        bf16_t* hp = base + (fq >> 1) * 128 + f0;
                        *(u32x4*)hp = pk8(ox); *(u32x4*)(hp + 16) = pk8(oy);
                    } else { *(u32x4*)(base + pos0) = pk8(X); *(u32x4*)(base + 128 + pos0) = pk8(Y); }
                } else if (pn < 12) {
                    bf16_t* base = vbuf + (size_t)row * KVP + (pn - 8) * 256 + pos0;
                    *(u32x4*)base = pk8(X); *(u32x4*)(base + 128) = pk8(Y);
                } else if (pn < 14) {
                    bf16_t* base = qi + (size_t)row * QIP + (pn - 12) * 256;
                    if (wc == 0) {
                        const f32x4* cp = (const f32x4*)(ropeI + (size_t)row * 8); float ox[8], oy[8];
#pragma unroll
                        for (int e2 = 0; e2 < 4; ++e2) { const f32x4 cs = cp[e2];
                            ox[2 * e2] = X[2 * e2] * cs[0] - Y[2 * e2] * cs[1]; oy[2 * e2] = Y[2 * e2] * cs[0] + X[2 * e2] * cs[1];
                            ox[2 * e2 + 1] = X[2 * e2 + 1] * cs[2] - Y[2 * e2 + 1] * cs[3]; oy[2 * e2 + 1] = Y[2 * e2 + 1] * cs[2] + X[2 * e2 + 1] * cs[3]; }
                        *(u32x4*)(base + fq * 64) = pk8(ox); *(u32x4*)(base + fq * 64 + 8) = pk8(oy);
                    } else { const int q0 = pos0 - 32, hh = (q0 >= 48) ? 1 : 0, d = 16 + q0 - 48 * hh;
                        *(u32x4*)(base + hh * 64 + d) = pk8(X); *(u32x4*)(base + (2 + hh) * 64 + d) = pk8(Y); }
                } else {
                    if (pos0 == 0) {
                        const f32x4* cp = (const f32x4*)(ropeI + (size_t)row * 8); float ox[8], oy[8];
#pragma unroll
                        for (int e2 = 0; e2 < 4; ++e2) { const f32x4 cs = cp[e2];
                            ox[2 * e2] = X[2 * e2] * cs[0] - Y[2 * e2] * cs[1]; oy[2 * e2] = Y[2 * e2] * cs[0] + X[2 * e2] * cs[1];
                            ox[2 * e2 + 1] = X[2 * e2 + 1] * cs[2] - Y[2 * e2 + 1] * cs[3]; oy[2 * e2 + 1] = Y[2 * e2 + 1] * cs[2] + X[2 * e2 + 1] * cs[3]; }
                        *(u32x4*)(ki + (size_t)row * 64) = pk8(ox); *(u32x4*)(ki + (size_t)row * 64 + 8) = pk8(oy);
                    } else if (pos0 < 56) { *(u32x4*)(ki + (size_t)row * 64 + 8 + pos0) = pk8(X); }
                    else if (pos0 < 80) { float* mp = misc + (size_t)row * 32 + (pos0 - 56);
                        *(f32x4*)mp = (f32x4){X[0], X[1], X[2], X[3]}; *(f32x4*)(mp + 4) = (f32x4){X[4], X[5], X[6], X[7]}; }
                }
                asm volatile("" ::: "memory");
            }
    }
};

template <bool HALF_ONLY> struct EpiMixProbe {
    static constexpr bool PERM = true, AFTER_DRAIN = false, KSCALE = false, PREP = false;
    bf16_t* dstbase;
    DI void operator()(const f32x4 (&acc)[2][2][4][2], const pg8::Unit& u, int wr, int wc, int fr, int fq) const {
        const int row0 = u.pm * 256 + wr * 64 + fr, colt = wc * 32 + 8 * fq; const int pn = u.pn;
        bf16_t* dst = dstbase + (pn % 6) * 256; const int ld = XBP;
#pragma unroll
        for (int ai = 0; ai < 2; ++ai)
#pragma unroll
            for (int m = 0; m < 4; ++m) {
                const int row = row0 + ai * 128 + m * 16;
#pragma unroll
                for (int bj = 0; bj < (HALF_ONLY ? 1 : 2); ++bj) {
                    const f32x4 a = acc[ai][bj][m][0] + acc[ai][1][m][0], b = acc[ai][bj][m][1] + acc[ai][1][m][1];
                    u32x4 w = {pk2(a[0], a[1]), pk2(a[2], a[3]), pk2(b[0], b[1]), pk2(b[2], b[3])};
                    *(u32x4*)(dst + (size_t)row * ld + bj * 128 + colt) = w;
                }
            }
    }
};
struct EpiStoreOnly {
    static constexpr bool PERM = true, AFTER_DRAIN = false, KSCALE = false, PREP = false;
    bf16_t* act;
    DI void operator()(const f32x4 (&acc)[2][2][4][2], const pg8::Unit& u, int wr, int wc, int fr, int fq) const {
        const int row0 = u.pm * 256 + wr * 64 + fr, col = u.pn * 128 + wc * 32 + 8 * fq;
#pragma unroll
        for (int ai = 0; ai < 2; ++ai)
#pragma unroll
            for (int m = 0; m < 4; ++m) {
                const int row = row0 + ai * 128 + m * 16;
                const f32x4 a = acc[ai][0][m][0] + acc[ai][1][m][0], b2 = acc[ai][0][m][1] + acc[ai][1][m][1];
                u32x4 w = {pk2(a[0], a[1]), pk2(a[2], a[3]), pk2(b2[0], b2[1]), pk2(b2[2], b2[3])};
                *(u32x4*)(act + (size_t)row * ACTP + col) = w;
            }
    }
};
struct EpiNull {
    static constexpr bool PERM = true, AFTER_DRAIN = false, KSCALE = false, PREP = false;
    float* dst;
    DI void operator()(const f32x4 (&acc)[2][2][4][2], const pg8::Unit& u, int wr, int wc, int fr, int fq) const {
        f32x4 s = {0.f, 0.f, 0.f, 0.f};
#pragma unroll
        for (int ai = 0; ai < 2; ++ai)
#pragma unroll
            for (int bj = 0; bj < 2; ++bj)
#pragma unroll
                for (int m = 0; m < 4; ++m)
#pragma unroll
                    for (int n = 0; n < 2; ++n) s += acc[ai][bj][m][n];
        *(f32x4*)(dst + ((size_t)(u.pm * 22 + u.pn) * 512 + threadIdx.x) * 4) = s;
    }
};

DI void phase_pro(const Ctx& c_in) {
    Ctx c = c_in; { int t_ = c.tid; asm volatile("" : "+v"(t_)); c.tid = t_; c.lane = t_ & 63; }
    const int gw = blockIdx.x * 8 + c.wid, nw = gridDim.x * 8;
    const float* xin = c.x(); const int* posp = c.pos();
    for (int row = gw; row < MTOK; row += nw) {
        const f32x4* src = (const f32x4*)(xin + (size_t)row * DM); float ss = 0.f;
#pragma unroll
        for (int j = 0; j < 4; ++j) {
            const f32x4 v = src[j * 64 + c.lane];
            u32x2 w = {pk2(v[0], v[1]), pk2(v[2], v[3])}; *(u32x2*)(c.hb() + (size_t)row * HBP + j * 256 + c.lane * 4) = w;
            ss += (v[0] * v[0] + v[1] * v[1]) + (v[2] * v[2] + v[3] * v[3]);
        }
#pragma unroll
        for (int o = 32; o >= 1; o >>= 1) ss += __shfl_xor(ss, o);
        if (c.lane < 16) c.ssp()[(size_t)row * 16 + c.lane] = (c.lane == 0) ? ss : 0.f;
    }
    const int gt = blockIdx.x * NTHR + c.tid, nt = gridDim.x * NTHR;
    for (int i = gt; i < MTOK * 24; i += nt) {
        const int t = i / 24, f = i % 24;
        const float ang = (float)posp[t] * *(const float __attribute__((address_space(4)))*)(karg_base() + 160 + 4 * f);
        const double rev = (double)ang * 0.15915494309189533577; const double fr = rev - __builtin_rint(rev);
        const float r = (float)fr;
        const f32x2 cs = {__builtin_amdgcn_cosf(r), __builtin_amdgcn_sinf(r)};
        if (f < 16) c.ropeA()[(size_t)t * 16 + f] = cs; else c.ropeI()[(size_t)t * 8 + (f - 16)] = cs;
    }
}

template <int MAP> DI int wmap(int n) {
    if (MAP == 0) return n;
    if (MAP == 1) { const int pn = n >> 8, bj = (n >> 7) & 1, jj = n & 127; return bj * DFF + pn * 128 + jj; }
    const int pn = n >> 8, bj = (n >> 7) & 1, pos = n & 127;
    if (pn < 8) {
        const int base = (pn < 4) ? 2576 : 3600, pp = pn & 3; int head, d;
        if (pos < 16) { head = 2 * pp; d = pos + 16 * bj; }
        else if (pos < 32) { head = 2 * pp + 1; d = (pos - 16) + 16 * bj; }
        else { head = 2 * pp + bj; d = pos; }
        return base + head * 128 + d;
    }
    if (pn < 12) return 4624 + (n - 2048);
    if (pn < 14) {
        const int hA = 4 * (pn - 12); int head, d;
        if (pos < 32) { head = hA + (pos >> 3); d = (pos & 7) + 8 * bj; }
        else { const int q = pos - 32; head = hA + 2 * bj + (q >= 48 ? 1 : 0); d = 16 + (q >= 48 ? q - 48 : q); }
        return 5648 + head * 64 + d;
    }
    if (bj == 0) {
        if (pos < 8) return 6160 + pos;
        if (pos < 56) return 6160 + 8 + pos;
        if (pos < 72) return 2560 + (pos - 56);
        if (pos < 80) return 6224 + (pos - 72);
        return -1;
    }
    return (pos < 8) ? 6168 + pos : -1;
}
template <int MAP> DI void convert_w(const Ctx& c_in, const float* W, int K, int Nsrc, bf16_t* Bt, int Nout, const float* gain, int klim, float scale) {
    Ctx c = c_in; { int t_ = c.tid; asm volatile("" : "+v"(t_)); c.tid = t_; c.lane = t_ & 63; }
    LAS float* tile = (LAS float*)c.lds;
    const int nkt = K / 64, ntiles = (Nout / 64) * nkt;
    const int n4 = (c.tid & 15) * 4, kl = c.tid >> 4;
    const int sn = c.tid >> 3, sk = (c.tid & 7) * 8;
    f32x4 r0, r1; int buf = 0;
    int t = blockIdx.x;
    if (t < ntiles) {
        const int n0 = (t / nkt) * 64, k0 = (t % nkt) * 64, src = wmap<MAP>(n0 + n4); const int srcc = src >= 0 ? src : 0;
        r0 = *(const f32x4*)(W + (size_t)(k0 + kl) * Nsrc + srcc); r1 = *(const f32x4*)(W + (size_t)(k0 + kl + 32) * Nsrc + srcc);
        if (src < 0) { r0 = (f32x4){0.f, 0.f, 0.f, 0.f}; r1 = r0; }
    }
    for (; t < ntiles; t += gridDim.x) {
        const int n0 = (t / nkt) * 64, k0 = (t % nkt) * 64;
        {
            const float g0 = ((gain != nullptr && k0 + kl < klim) ? gain[k0 + kl] : 1.f) * scale, g1 = ((gain != nullptr && k0 + kl + 32 < klim) ? gain[k0 + kl + 32] : 1.f) * scale;
            LAS float* tb = tile + buf * (64 * 65);
#pragma unroll
            for (int e = 0; e < 4; ++e) { tb[kl * 65 + n4 + e] = r0[e] * g0; tb[(kl + 32) * 65 + n4 + e] = r1[e] * g1; }
        }
        __syncthreads();
        const int t2 = t + gridDim.x;
        if (t2 < ntiles) {
            const int n02 = (t2 / nkt) * 64, k02 = (t2 % nkt) * 64, src = wmap<MAP>(n02 + n4); const int srcc = src >= 0 ? src : 0;
            r0 = *(const f32x4*)(W + (size_t)(k02 + kl) * Nsrc + srcc); r1 = *(const f32x4*)(W + (size_t)(k02 + kl + 32) * Nsrc + srcc);
            if (src < 0) { r0 = (f32x4){0.f, 0.f, 0.f, 0.f}; r1 = r0; }
        }
        {
            const LAS float* tb = tile + buf * (64 * 65);
            u32x4 w;
#pragma unroll
            for (int e = 0; e < 4; ++e) w[e] = pk2(tb[(sk + 2 * e) * 65 + sn], tb[(sk + 2 * e + 1) * 65 + sn]);
            *(u32x4*)(Bt + (size_t)(n0 + sn) * K + k0 + sk) = w;
        }
        buf ^= 1;
    }
    __syncthreads();
}


#define WRLANE(dst, sval, ln) asm volatile("s_nop 3\n\tv_writelane_b32 %0, %1, %2" : "+v"(dst) : "s"(sval), "n"(ln))
DI unsigned ord_key(float v) { const unsigned u = __float_as_uint(v); return u ^ ((u & 0x80000000u) ? 0xffffffffu : 0x80000000u); }
DI void sel_load_q(const Ctx& c, int u, int c32, int hi, bf16x8 (&af)[2][4], float (&wv)[2][4][4]) {
    const int t8 = (SEQ / 8 - 1) - (u >> 2), b = u & 3; const size_t tok0 = (size_t)b * SEQ + t8 * 8;
#pragma unroll
    for (int mt = 0; mt < 2; ++mt) {
        const size_t tq = tok0 + 4 * mt + (c32 >> 3);
#pragma unroll
        for (int ks = 0; ks < 4; ++ks) af[mt][ks] = *(const bf16x8*)(c.qi() + tq * QIP + (c32 & 7) * 64 + 16 * ks + 8 * hi);
#pragma unroll
        for (int tl = 0; tl < 4; ++tl) { const f32x4 w4 = *(const f32x4*)(c.misc() + (tok0 + 4 * mt + tl) * 32 + 16 + 4 * hi);
            wv[mt][tl][0] = w4[0]; wv[mt][tl][1] = w4[1]; wv[mt][tl][2] = w4[2]; wv[mt][tl][3] = w4[3]; }
    }
}
DI void sel_load_kgroup(const bf16_t* kbase, int kt0, int nkt, bf16x8 (&b)[4][4]) {
#pragma unroll
    for (int j = 0; j < 4; ++j) { const int kt = (kt0 + 8 * j < nkt) ? kt0 + 8 * j : nkt - 1;
#pragma unroll
        for (int ks = 0; ks < 4; ++ks) b[j][ks] = *(const bf16x8*)(kbase + (size_t)kt * 32 * 64 + 16 * ks); }
}
DI void sel_score_group(const bf16x8 (&af)[2][4], const float (&wv)[2][4][4], const bf16x8 (&b)[4][4], LAS float* sc, int kt0, int nkt, int c32, int hi) {
#pragma unroll
    for (int j = 0; j < 4; ++j) { const int kt = kt0 + 8 * j;
        if (kt < nkt) {
            const int s0 = kt * 32;
#pragma unroll
            for (int mt = 0; mt < 2; ++mt) {
                f32x16 acc = {};
#pragma unroll
                for (int ks = 0; ks < 4; ++ks) acc = MFMA32(af[mt][ks], b[j][ks], acc);
                float tot[4];
#pragma unroll
                for (int tl = 0; tl < 4; ++tl) {
                    float p = 0.f;
#pragma unroll
                    for (int jj = 0; jj < 4; ++jj) p += wv[mt][tl][jj] * fmaxf(acc[4 * tl + jj], 0.f);
                    const auto rr = __builtin_amdgcn_permlane32_swap(__float_as_uint(p), __float_as_uint(p), false, false);
                    tot[tl] = (__uint_as_float(rr[0]) + __uint_as_float(rr[1])) + 0.0f;
                }
                const int ql = 4 * mt + 2 * hi;
                sc[ql * 4096 + s0 + c32] = hi ? tot[2] : tot[0];
                sc[(ql + 1) * 4096 + s0 + c32] = hi ? tot[3] : tot[1];
            }
        } }
}
DI void sel_score_tile(const bf16x8 (&af)[2][4], const float (&wv)[2][4][4], const bf16x8 (&b)[4], LAS float* sc, int s0, int c32, int hi) {
#pragma unroll
    for (int mt = 0; mt < 2; ++mt) {
        f32x16 acc = {};
#pragma unroll
        for (int ks = 0; ks < 4; ++ks) acc = MFMA32(af[mt][ks], b[ks], acc);
        float tot[4];
#pragma unroll
        for (int tl = 0; tl < 4; ++tl) {
            float p = 0.f;
#pragma unroll
            for (int jj = 0; jj < 4; ++jj) p += wv[mt][tl][jj] * fmaxf(acc[4 * tl + jj], 0.f);
            const auto rr = __builtin_amdgcn_permlane32_swap(__float_as_uint(p), __float_as_uint(p), false, false);
            tot[tl] = (__uint_as_float(rr[0]) + __uint_as_float(rr[1])) + 0.0f;
        }
        const int ql = 4 * mt + 2 * hi;
        sc[ql * 4096 + s0 + c32] = hi ? tot[2] : tot[0];
        sc[(ql + 1) * 4096 + s0 + c32] = hi ? tot[3] : tot[1];
    }
}
DI void phase_select(const Ctx& c_in) {
    Ctx c = c_in; { int t_ = c.tid; asm volatile("" : "+v"(t_)); c.tid = t_; c.lane = t_ & 63; }
    LAS float* sc = (LAS float*)c.lds;
    const int lane = c.lane, wid = c.wid, c32 = lane & 31, hi = lane >> 5;
    bf16x8 af[2][4]; float wv[2][4][4];
    const int G_ = (int)gridDim.x, bx_ = (int)blockIdx.x, NU_ = NB * (SEQ / 8);
#define SEL_UNIT(r) ((r) * G_ + (((r) & 1) ? G_ - 1 - bx_ : bx_))
    if (SEL_UNIT(0) < NU_) sel_load_q(c, SEL_UNIT(0), c32, hi, af, wv);
    for (int rnd = 0; SEL_UNIT(rnd) < NU_; ++rnd) {
        const int u = SEL_UNIT(rnd);
        const int t8 = (SEQ / 8 - 1) - (u >> 2), b = u & 3, t0 = t8 * 8;
        const int nkt = (t0 + 7) / 32 + 1;
        const bf16_t* kbase = c.ki() + ((size_t)b * SEQ + c32) * 64 + 8 * hi;
        {
            bf16x8 bcur[4], bnxt[4];
            { const int kt = (wid < nkt) ? wid : nkt - 1;
#pragma unroll
              for (int ks = 0; ks < 4; ++ks) bcur[ks] = *(const bf16x8*)(kbase + (size_t)kt * 32 * 64 + 16 * ks); }
            for (int kt = wid; kt < nkt; kt += 8) {
                { const int k2 = (kt + 8 < nkt) ? kt + 8 : nkt - 1;
#pragma unroll
                  for (int ks = 0; ks < 4; ++ks) bnxt[ks] = *(const bf16x8*)(kbase + (size_t)k2 * 32 * 64 + 16 * ks); }
                sel_score_tile(af, wv, bcur, sc, kt * 32, c32, hi);
#pragma unroll
                for (int ks = 0; ks < 4; ++ks) bcur[ks] = bnxt[ks];
            }
        }
        if (SEL_UNIT(rnd + 1) < NU_) sel_load_q(c, SEL_UNIT(rnd + 1), c32, hi, af, wv);
        __syncthreads();
        {
            int lane_ = c.lane; asm volatile("" : "+v"(lane_)); const int lane = lane_;
            const int t = t0 + wid; unsigned mlo = 0u, mhi = 0u;
            if (t < 256) {
#pragma unroll
                for (int r = 0; r < 64; ++r) {
                    const unsigned long long bal = __ballot(r * 64 + lane <= t);
                    WRLANE(mlo, (unsigned)bal, r); WRLANE(mhi, (unsigned)(bal >> 32), r);
                    __builtin_amdgcn_sched_barrier(0);
                }
            } else {
                unsigned key[64];
                const int nreg = (t >> 6) + 1;
#pragma unroll
                for (int r = 0; r < 64; ++r) { const int s = r * 64 + lane; const float v = sc[wid * 4096 + s]; key[r] = (s <= t) ? ord_key(v) : 0u; }
#ifndef PROBE_BITS
#define PROBE_BITS 1
#endif
                unsigned T = 0u; int cge = 4096;
                for (int rep = 0; rep < PROBE_BITS; ++rep) { T = 0u;
                for (int bit = 31; bit >= 0; --bit) {
                    const unsigned cand = T | (1u << bit); int cnt = 0;
#pragma unroll
                    for (int g = 0; g < 8; ++g) {
                        if (g * 8 < nreg) {
                            { unsigned long long m0 = __ballot(key[g * 8] >= cand), m1 = __ballot(key[g * 8 + 1] >= cand), m2 = __ballot(key[g * 8 + 2] >= cand), m3 = __ballot(key[g * 8 + 3] >= cand),
                                                 m4 = __ballot(key[g * 8 + 4] >= cand), m5 = __ballot(key[g * 8 + 5] >= cand), m6 = __ballot(key[g * 8 + 6] >= cand), m7 = __ballot(key[g * 8 + 7] >= cand);
                              asm volatile("" : "+s"(m0), "+s"(m1), "+s"(m2), "+s"(m3), "+s"(m4), "+s"(m5), "+s"(m6), "+s"(m7));
                              cnt += (__popcll(m0) + __popcll(m1)) + (__popcll(m2) + __popcll(m3)) + ((__popcll(m4) + __popcll(m5)) + (__popcll(m6) + __popcll(m7))); }
                        }
                        __builtin_amdgcn_sched_barrier(0);
                    }
                    if (cnt >= 256) { T = cand; cge = cnt; if (cnt == 256) break; }
                } }
#ifndef PROBE_FINAL
#define PROBE_FINAL 1
#endif
                for (int repf = 0; repf < PROBE_FINAL; ++repf) {
                if (cge == 256) {
#pragma unroll
                    for (int g = 0; g < 8; ++g) {
                        if (g * 8 < nreg) {
#pragma unroll
                            for (int rr = 0; rr < 8; ++rr) { const unsigned long long word = __ballot(key[g * 8 + rr] >= T);
                                WRLANE(mlo, (unsigned)word, g * 8 + rr); WRLANE(mhi, (unsigned)(word >> 32), g * 8 + rr); }
                        }
                        __builtin_amdgcn_sched_barrier(0);
                    }
                } else {
                int cgt = 0;
#pragma unroll
                for (int g = 0; g < 8; ++g) {
#pragma unroll
                    for (int rr = 0; rr < 8; ++rr) cgt += __popcll(__ballot(key[g * 8 + rr] > T));
                    __builtin_amdgcn_sched_barrier(0);
                }
                int need = 256 - cgt;
#pragma unroll
                for (int r = 0; r < 64; ++r) {
                    const unsigned long long gt = __ballot(key[r] > T); unsigned long long eq = __ballot(key[r] == T), take;
                    const int ne = __popcll(eq);
                    if (ne <= need) { take = eq; need -= ne; }
                    else { take = 0ull; while (need > 0) { const unsigned long long low = eq & (0ull - eq); take |= low; eq ^= low; --need; } }
                    const unsigned long long word = gt | take;
                    WRLANE(mlo, (unsigned)word, r); WRLANE(mhi, (unsigned)(word >> 32), r);
                    __builtin_amdgcn_sched_barrier(0);
                }
                }
                }
            }
            u32x2 w = {mlo, mhi};
            *(u32x2*)(c.mask() + ((size_t)b * SEQ + t) * 128 + 2 * lane) = w;
        }
        __syncthreads();
    }
}

constexpr int VT_PITCH = 136;
#define KSW(row) ((((row) & 7) | ((((row) >> 4) & 1) << 3)) << 4)
constexpr int ATT_KBUF = 16384, ATT_VBUF = 128 * VT_PITCH, ATT_K_OFF = 0, ATT_V_OFF = 2 * ATT_KBUF;
constexpr float ATT_C2 = 0.08838834764831845f * 1.4426950408889634f, ATT_THR = 8.0f;
DI void att_S(const LAS unsigned char* Kr, const bf16x8 (&qr)[8], int c32, int hi, f32x16& p0, f32x16& p1) {
    p0 = (f32x16){}; p1 = (f32x16){};
#pragma unroll
    for (int g = 0; g < 4; ++g) {
        bf16x8 a0[2], a1[2];
#pragma unroll
        for (int dd = 0; dd < 2; ++dd) { const int ch = 2 * (2 * g + dd) + hi;
            a0[dd] = *(const LAS bf16x8*)(Kr + c32 * 256 + ((ch * 16) ^ KSW(c32)));
            a1[dd] = *(const LAS bf16x8*)(Kr + (c32 + 32) * 256 + ((ch * 16) ^ KSW(c32))); }
#pragma unroll
        for (int dd = 0; dd < 2; ++dd) { p0 = MFMA32(a0[dd], qr[2 * g + dd], p0); p1 = MFMA32(a1[dd], qr[2 * g + dd], p1); }
    }
}
DI void att_SM(f32x16& p0, f32x16& p1, u32x2 mcur, int hi, float& m_run, float& l_run, f32x16 (&o)[4], bf16x8 (&pb)[4]) {
    const float NEG = -__builtin_inff();
    const unsigned w0 = mcur[0] >> (4 * hi), w1 = mcur[1] >> (4 * hi);
    float tmax = NEG;
#pragma unroll
    for (int r = 0; r < 16; ++r) {
        const int bp = (r & 3) + 8 * (r >> 2);
        const unsigned m0 = (unsigned)__builtin_amdgcn_sbfe((int)w0, bp, 1), m1 = (unsigned)__builtin_amdgcn_sbfe((int)w1, bp, 1);
        p0[r] = __uint_as_float((__float_as_uint(p0[r]) & m0) | (0xff800000u & ~m0)); p1[r] = __uint_as_float((__float_as_uint(p1[r]) & m1) | (0xff800000u & ~m1));
        tmax = fmaxf(tmax, fmaxf(p0[r], p1[r]));
    }
    { const auto rr = __builtin_amdgcn_permlane32_swap(__float_as_uint(tmax), __float_as_uint(tmax), false, false); tmax = fmaxf(__uint_as_float(rr[0]), __uint_as_float(rr[1])); }
    if (!__all((tmax - m_run) * 0.08838834764831845f <= ATT_THR)) {
        const float mn = fmaxf(m_run, tmax); const float alpha = __builtin_amdgcn_exp2f((m_run - mn) * ATT_C2); m_run = mn;
        l_run *= alpha;
#pragma unroll
        for (int db = 0; db < 4; ++db)
#pragma unroll
            for (int r = 0; r < 16; ++r) o[db][r] *= alpha;
    }
    const float mnl = -m_run * ATT_C2; float ps = 0.f;
#pragma unroll
    for (int r = 0; r < 16; ++r) { p0[r] = __builtin_amdgcn_exp2f(fmaf(p0[r], ATT_C2, mnl)); p1[r] = __builtin_amdgcn_exp2f(fmaf(p1[r], ATT_C2, mnl)); ps += p0[r] + p1[r]; }
    l_run += ps;
    pb[0] = pack8((f32x4){p0[0], p0[1], p0[2], p0[3]}, (f32x4){p0[4], p0[5], p0[6], p0[7]});
    pb[1] = pack8((f32x4){p0[8], p0[9], p0[10], p0[11]}, (f32x4){p0[12], p0[13], p0[14], p0[15]});
    pb[2] = pack8((f32x4){p1[0], p1[1], p1[2], p1[3]}, (f32x4){p1[4], p1[5], p1[6], p1[7]});
    pb[3] = pack8((f32x4){p1[8], p1[9], p1[10], p1[11]}, (f32x4){p1[12], p1[13], p1[14], p1[15]});
}
DI void att_PV(const LAS unsigned char* Vr, const bf16x8 (&pb)[4], f32x16 (&o)[4], int c32, int hi) {
#pragma unroll
    for (int db = 0; db < 4; ++db) {
        s16x4 lo[4], hh[4];
#pragma unroll
        for (int ks = 0; ks < 4; ++ks) { const LAS unsigned char* vp = Vr + (32 * db + c32) * VT_PITCH + (16 * ks + 4 * hi) * 2;
            lo[ks] = *(const LAS s16x4*)vp; hh[ks] = *(const LAS s16x4*)(vp + 16); }
#pragma unroll
        for (int ks = 0; ks < 4; ++ks) { const bf16x8 a = {lo[ks][0], lo[ks][1], lo[ks][2], lo[ks][3], hh[ks][0], hh[ks][1], hh[ks][2], hh[ks][3]};
            o[db] = MFMA32(a, pb[ks], o[db]); }
    }
}
DI void phase_attn(const Ctx& c_in, const int dummy) {
    Ctx c = c_in; { int t_ = c.tid; asm volatile("" : "+v"(t_)); c.tid = t_; c.lane = t_ & 63; }
    LAS unsigned char* Kl = c.lds + ATT_K_OFF; LAS unsigned char* Vl = c.lds + ATT_V_OFF;
    const int lane = c.lane, wid = c.wid, tid = c.tid, c32 = lane & 31, hi = lane >> 5;
    for (int u = blockIdx.x; u < NB * 8 * 8; u += gridDim.x) {
        const int x = u & 7, hd = (u >> 3) & 7, b = u >> 6;
        for (int half = 0; half < 2; ++half) {
            const int qb = half ? 15 - x : x, P0 = qb * 256; const size_t tq = (size_t)b * SEQ + P0 + 32 * wid + c32;
            bf16_t* qptr = c.ymix() + tq * YP + 1024 + hd * 128;
            bf16x8 qr[8];
#pragma unroll
            for (int d0 = 0; d0 < 8; ++d0) qr[d0] = *(const bf16x8*)(qptr + 16 * d0 + 8 * hi);
            float m_run = -1e30f, l_run = 0.f; f32x16 o[4] = {};
            const int ntiles = P0 / 64 + 4;
            const bf16_t* kbase = c.kbuf() + (size_t)b * SEQ * KVP + hd * 128; const bf16_t* vbase = c.vbuf() + (size_t)b * SEQ * KVP + hd * 128;
            const unsigned* mrow = c.mask() + tq * 128;
            bf16x8 sk0, sk1, sv0, sv1;
#define ATT_LOAD(jt) do { const size_t k0_ = (size_t)(jt) * 64; \
                sk0 = *(const bf16x8*)(kbase + (k0_ + (tid >> 4)) * KVP + (tid & 15) * 8); sk1 = *(const bf16x8*)(kbase + (k0_ + 32 + (tid >> 4)) * KVP + (tid & 15) * 8); \
                sv0 = *(const bf16x8*)(vbase + (k0_ + lane) * KVP + 16 * wid); sv1 = *(const bf16x8*)(vbase + (k0_ + lane) * KVP + 16 * wid + 8); } while (0)
#define ATT_WRITE(kb, vb) do { LAS unsigned char* Kw = Kl + (kb) * ATT_KBUF; LAS unsigned char* Vw = Vl + (vb) * ATT_VBUF; const int key_ = tid >> 4, ch_ = tid & 15; \
                *(LAS bf16x8*)(Kw + key_ * 256 + ((ch_ * 16) ^ KSW(key_))) = sk0; *(LAS bf16x8*)(Kw + (key_ + 32) * 256 + ((ch_ * 16) ^ KSW(key_))) = sk1; \
                _Pragma("unroll") for (int e = 0; e < 8; ++e) { *(LAS short*)(Vw + (16 * wid + e) * VT_PITCH + lane * 2) = sv0[e]; *(LAS short*)(Vw + (16 * wid + 8 + e) * VT_PITCH + lane * 2) = sv1[e]; } } while (0)
            __syncthreads();
            ATT_LOAD(0); ATT_WRITE(0, 0);
            if (ntiles > 1) ATT_LOAD(1);
            u32x2 mw = *(const u32x2*)(mrow);
            __syncthreads();
#define ATT_STEP_HEAD() \
                const int kb = j & 1; int vnext = vcur + 1; if (vnext == 3) vnext = 0; \
                if (j + 1 < ntiles) ATT_WRITE(kb ^ 1, vnext); \
                if (j + 2 < ntiles) ATT_LOAD(j + 2); \
                const u32x2 mcur = mw; \
                if (j + 1 < ntiles) mw = *(const u32x2*)(mrow + 2 * (j + 1)); \
                const LAS unsigned char* Kr = Kl + kb * ATT_KBUF;
            if (wid < 4) {
                int vcur = 0;
                for (int j = 0; j < ntiles; ++j) {
                    ATT_STEP_HEAD()
                    f32x16 p0, p1; bf16x8 pb[4];
                    att_S(Kr, qr, c32, hi, p0, p1);
                    att_SM(p0, p1, mcur, hi, m_run, l_run, o, pb); att_PV(Vl + vcur * ATT_VBUF, pb, o, c32, hi);
                    vcur = vnext;
                    __syncthreads();
                }
            } else {
                bf16x8 pb[4] = {}; int vprev = 0, vcur = 0;
                for (int j = 0; j < ntiles; ++j) {
                    ATT_STEP_HEAD()
                    att_PV(Vl + vprev * ATT_VBUF, pb, o, c32, hi);
                    f32x16 p0, p1;
                    att_S(Kr, qr, c32, hi, p0, p1);
                    att_SM(p0, p1, mcur, hi, m_run, l_run, o, pb);
                    vprev = vcur; vcur = vnext;
                    __syncthreads();
                }
                att_PV(Vl + vprev * ATT_VBUF, pb, o, c32, hi);
            }
#undef ATT_STEP_HEAD
#undef ATT_LOAD
#undef ATT_WRITE
            l_run += __shfl_xor(l_run, 32);
            const float rl = 1.0f / l_run;
#pragma unroll
            for (int db = 0; db < 4; ++db)
#pragma unroll
                for (int g = 0; g < 4; ++g) {
                    u32x2 w = {pk2(o[db][4 * g] * rl, o[db][4 * g + 1] * rl), pk2(o[db][4 * g + 2] * rl, o[db][4 * g + 3] * rl)};
                    *(u32x2*)((dummy ? qptr - 1024 : qptr) + 32 * db + 8 * g + 4 * hi) = w;
                }
        }
    }
}

template <int NT> DI void conv_seg(const bf16_t* xbc, size_t tok_first, int pos_first, int cidx, const float* cw, const float* cb, float (&out)[NT][8]) {
    u32x4 rows[NT + 3];
#pragma unroll
    for (int i = 0; i < NT + 3; ++i) {
        const int off = i - 3, offc = (off < -pos_first) ? -pos_first : off;
        const u32x4 v = *(const u32x4*)(xbc + (size_t)((long)tok_first + offc) * XBP + cidx);
        const bool ok = (pos_first + off >= 0);
        rows[i] = (u32x4){ok ? v[0] : 0u, ok ? v[1] : 0u, ok ? v[2] : 0u, ok ? v[3] : 0u};
    }
    float w[4][8], bias[8];
#pragma unroll
    for (int k = 0; k < 4; ++k) { const f32x4 w0 = *(const f32x4*)(cw + k * XBCW + cidx), w1 = *(const f32x4*)(cw + k * XBCW + cidx + 4);
        w[k][0] = w0[0]; w[k][1] = w0[1]; w[k][2] = w0[2]; w[k][3] = w0[3]; w[k][4] = w1[0]; w[k][5] = w1[1]; w[k][6] = w1[2]; w[k][7] = w1[3]; }
    { const f32x4 b0 = *(const f32x4*)(cb + cidx), b1 = *(const f32x4*)(cb + cidx + 4);
      bias[0] = b0[0]; bias[1] = b0[1]; bias[2] = b0[2]; bias[3] = b0[3]; bias[4] = b1[0]; bias[5] = b1[1]; bias[6] = b1[2]; bias[7] = b1[3]; }
#pragma unroll
    for (int j = 0; j < NT; ++j)
#pragma unroll
        for (int e = 0; e < 8; ++e) {
            float a = bias[e];
#pragma unroll
            for (int k = 0; k < 4; ++k) { const unsigned wd = rows[j + k][e >> 1]; a += w[k][e] * ((e & 1) ? bfhi(wd) : bflo(wd)); }
            out[j][e] = silu_f(a);
        }
}
constexpr int SSD_PITCH = 264;
DI void ssd_dt_scan(const Ctx& c, LAS float* dtl, LAS float* acs, size_t tok0, int h, const float* dt_bias, const float* a_log) {
    if (c.tid < 256) {
        const float v = c.misc()[(tok0 + c.tid) * 32 + h] + dt_bias[h];
        const float sp = fmaxf(v, 0.f) + log1pf(__expf(-fabsf(v)));
        dtl[c.tid] = sp;
    }
    __syncthreads();
    if (c.wid == 0) {
        const float a = -__expf(a_log[h]);
        const float a0 = dtl[4 * c.lane] * a, a1 = dtl[4 * c.lane + 1] * a, a2 = dtl[4 * c.lane + 2] * a, a3 = dtl[4 * c.lane + 3] * a;
        const float s1 = a0, s2 = s1 + a1, s3 = s2 + a2, s4 = s3 + a3; float tot = s4;
#pragma unroll
        for (int off = 1; off < 64; off <<= 1) { const float n = __shfl_up(tot, off); if (c.lane >= off) tot += n; }
        const float base = tot - s4;
        acs[4 * c.lane] = base + s1; acs[4 * c.lane + 1] = base + s2; acs[4 * c.lane + 2] = base + s3; acs[4 * c.lane + 3] = base + s4;
    }
    __syncthreads();
}
DI void phase_ssd_states(const Ctx& c_in, const float* cw, const float* cb, const float* dt_bias, const float* a_log) {
    Ctx c = c_in; { int t_ = c.tid; asm volatile("" : "+v"(t_)); c.tid = t_; c.lane = t_ & 63; }
    LAS bf16_t* XT = (LAS bf16_t*)c.lds;
    LAS bf16_t* BT = (LAS bf16_t*)(c.lds + 64 * SSD_PITCH * 2);
    LAS float* dtl = (LAS float*)(c.lds + 192 * SSD_PITCH * 2); LAS float* acs = dtl + 256;
    const int lane = c.lane, wid = c.wid, tid = c.tid, c32 = lane & 31, hi = lane >> 5;
    for (int u = blockIdx.x; u < 1024; u += gridDim.x) {
        const int h = u & 15, ch = (u >> 4) & 15, b = u >> 8, g = h >> 3; const size_t tok0 = (size_t)b * SEQ + ch * 256;
        ssd_dt_scan(c, dtl, acs, tok0, h, dt_bias, a_log);
        const float alast = acs[255];
        {
            const int oct = tid & 7, l0 = (tid >> 3) * 4; float v[4][8];
            conv_seg<4>(c.xbc(), tok0 + l0, ch * 256 + l0, h * 64 + oct * 8, cw, cb, v);
            float sc[4];
#pragma unroll
            for (int j = 0; j < 4; ++j) sc[j] = dtl[l0 + j] * __expf(alast - acs[l0 + j]);
#pragma unroll
            for (int e = 0; e < 8; ++e) { u32x2 w = {pk2(v[0][e] * sc[0], v[1][e] * sc[1]), pk2(v[2][e] * sc[2], v[3][e] * sc[3])}; *(LAS u32x2*)(XT + (oct * 8 + e) * SSD_PITCH + l0) = w; }
        }
        {
            const int oct = tid & 15, l0 = (tid >> 4) * 8; float v[8][8];
            conv_seg<8>(c.xbc(), tok0 + l0, ch * 256 + l0, 1024 + g * 128 + oct * 8, cw, cb, v);
#pragma unroll
            for (int e = 0; e < 8; ++e) { u32x4 w = {pk2(v[0][e], v[1][e]), pk2(v[2][e], v[3][e]), pk2(v[4][e], v[5][e]), pk2(v[6][e], v[7][e])}; *(LAS u32x4*)(BT + (oct * 8 + e) * SSD_PITCH + l0) = w; }
        }
        __syncthreads();
        const int pb = wid >> 2, nb = wid & 3; f32x16 acc = {};
#pragma unroll
        for (int ks = 0; ks < 16; ++ks) {
            const bf16x8 a = *(const LAS bf16x8*)(XT + (32 * pb + c32) * SSD_PITCH + 16 * ks + 8 * hi);
            const bf16x8 bb = *(const LAS bf16x8*)(BT + (32 * nb + c32) * SSD_PITCH + 16 * ks + 8 * hi);
            acc = MFMA32(a, bb, acc);
        }
        float* st = c.states() + (size_t)u * 8192;
#pragma unroll
        for (int r = 0; r < 16; ++r) st[(32 * pb + crow(r, hi)) * 128 + 32 * nb + c32] = acc[r];
        if (tid == 0) c.cdec()[u] = __expf(alast);
        __syncthreads();
    }
}
DI void phase_ssd_out(const Ctx& c_in, const float* cw, const float* cb, const float* dt_bias, const float* a_log, const float* d_skip, const int dummy) {
    Ctx c = c_in; { int t_ = c.tid; asm volatile("" : "+v"(t_)); c.tid = t_; c.lane = t_ & 63; }
    LAS unsigned char* Bn = c.lds;
    LAS bf16_t* XT = (LAS bf16_t*)(c.lds + 65536);
    LAS bf16_t* Hs = (LAS bf16_t*)(c.lds + 65536 + 64 * SSD_PITCH * 2);
    LAS float* dtl = (LAS float*)(c.lds + 65536 + 64 * SSD_PITCH * 2 + 64 * 136 * 2); LAS float* acs = dtl + 256;
    const int wid = c.wid;
    for (int su = blockIdx.x; su < 256; su += gridDim.x) {
      const int bh_ = su >> 2, cq_ = su & 3; f32x4 hs[4] = {};
      {
          const int p = c.tid >> 3, n0 = (c.tid & 7) * 16;
#pragma unroll 4
          for (int cc = 0; cc < 4 * cq_; ++cc) {
              const int u2 = (((bh_ >> 4) * 16 + cc) << 4) + (bh_ & 15); const float* sp = c.states() + (size_t)u2 * 8192 + p * 128 + n0; const float dec = c.cdec()[u2];
#pragma unroll
              for (int q = 0; q < 4; ++q) hs[q] = hs[q] * dec + *(const f32x4*)(sp + 4 * q);
          }
      }
      for (int ci = 0; ci < 4; ++ci) {
        const int u = (((bh_ >> 4) * 16 + 4 * cq_ + ci) << 4) + (bh_ & 15);
        int tid_ = c.tid; asm volatile("" : "+v"(tid_)); const int tid = tid_, lane = tid & 63, c32 = lane & 31, hi = lane >> 5;
        const int h = u & 15, ch = (u >> 4) & 15, b = u >> 8, g = h >> 3; const size_t tok0 = (size_t)b * SEQ + ch * 256;
        ssd_dt_scan(c, dtl, acs, tok0, h, dt_bias, a_log);
        {
            const int oct = tid & 15;
#pragma unroll 1
            for (int hf = 0; hf < 2; ++hf) { const int l0 = (tid >> 4) * 8 + 4 * hf; float v[4][8];
                conv_seg<4>(c.xbc(), tok0 + l0, ch * 256 + l0, 1280 + g * 128 + oct * 8, cw, cb, v);
#pragma unroll
                for (int j = 0; j < 4; ++j) { const int l = l0 + j;
                    *(LAS bf16x8*)(Bn + l * 256 + ((oct * 16) ^ ((l & 7) << 4))) = pack8((f32x4){v[j][0], v[j][1], v[j][2], v[j][3]}, (f32x4){v[j][4], v[j][5], v[j][6], v[j][7]}); } }
        }
        {
            const int oct = tid & 7, l0 = (tid >> 3) * 4; float v[4][8];
            conv_seg<4>(c.xbc(), tok0 + l0, ch * 256 + l0, h * 64 + oct * 8, cw, cb, v);
#pragma unroll
            for (int e = 0; e < 8; ++e) { u32x2 w = {pk2(v[0][e], v[1][e]), pk2(v[2][e], v[3][e])}; *(LAS u32x2*)(XT + (oct * 8 + e) * SSD_PITCH + l0) = w; }
        }
        {
            const int p = tid >> 3, n0 = (tid & 7) * 16;
            *(LAS bf16x8*)(Hs + p * 136 + n0) = pack8(hs[0], hs[1]); *(LAS bf16x8*)(Hs + p * 136 + n0 + 8) = pack8(hs[2], hs[3]);
            if (ci < 3) { const float* sp = c.states() + (size_t)u * 8192 + p * 128 + n0; const float dec = c.cdec()[u];
#pragma unroll
                for (int q = 0; q < 4; ++q) hs[q] = hs[q] * dec + *(const f32x4*)(sp + 4 * q); }
        }
        __syncthreads();
        const int l = 32 * wid + c32; bf16x8 qr[8];
#pragma unroll
        for (int ks = 0; ks < 8; ++ks) qr[ks] = *(const LAS bf16x8*)(Bn + l * 256 + (((2 * ks + hi) * 16) ^ ((l & 7) << 4)));
        __syncthreads();
        {
            const int oct = tid & 15;
#pragma unroll 1
            for (int hf = 0; hf < 2; ++hf) { const int l0 = (tid >> 4) * 8 + 4 * hf; float v[4][8];
                conv_seg<4>(c.xbc(), tok0 + l0, ch * 256 + l0, 1024 + g * 128 + oct * 8, cw, cb, v);
#pragma unroll
                for (int j = 0; j < 4; ++j) { const int l2 = l0 + j;
                    *(LAS bf16x8*)(Bn + l2 * 256 + ((oct * 16) ^ ((l2 & 7) << 4))) = pack8((f32x4){v[j][0], v[j][1], v[j][2], v[j][3]}, (f32x4){v[j][4], v[j][5], v[j][6], v[j][7]}); } }
        }
        __syncthreads();
        const float acs_l = acs[l], dsk = d_skip[h];
        f32x16 o[2] = {};
        for (int j = 0; j <= wid; ++j) {
            f32x16 p = {};
#pragma unroll
            for (int ks = 0; ks < 8; ++ks) {
                const int row = 32 * j + c32, chn = 2 * ks + hi;
                const bf16x8 a = *(const LAS bf16x8*)(Bn + row * 256 + ((chn * 16) ^ ((row & 7) << 4)));
                p = MFMA32(a, qr[ks], p);
            }
#pragma unroll
            for (int r = 0; r < 16; ++r) {
                const int s = 32 * j + crow(r, hi);
                float v = p[r] * __expf(acs_l - acs[s]) * dtl[s];
                v = (s <= l) ? v : 0.f;
                p[r] = (s == l) ? v + dsk : v;
            }
            bf16x8 pb[2];
            pb[0] = pack8((f32x4){p[0], p[1], p[2], p[3]}, (f32x4){p[4], p[5], p[6], p[7]});
            pb[1] = pack8((f32x4){p[8], p[9], p[10], p[11]}, (f32x4){p[12], p[13], p[14], p[15]});
#pragma unroll
            for (int pk = 0; pk < 2; ++pk)
#pragma unroll
                for (int ks = 0; ks < 2; ++ks) {
                    const LAS bf16_t* xp = XT + (32 * pk + c32) * SSD_PITCH + 32 * j + 16 * ks + 4 * hi;
                    const s16x4 lo = *(const LAS s16x4*)xp, hh = *(const LAS s16x4*)(xp + 8);
                    const bf16x8 a = {lo[0], lo[1], lo[2], lo[3], hh[0], hh[1], hh[2], hh[3]};
                    o[pk] = MFMA32(a, pb[ks], o[pk]);
                }
        }
        {
            f32x16 o2[2] = {};
#pragma unroll
            for (int pk = 0; pk < 2; ++pk)
#pragma unroll
                for (int ks = 0; ks < 8; ++ks) {
                    const bf16x8 a = *(const LAS bf16x8*)(Hs + (32 * pk + c32) * 136 + 16 * ks + 8 * hi);
                    o2[pk] = MFMA32(a, qr[ks], o2[pk]);
                }
            const float el = __expf(acs_l);
#pragma unroll
            for (int pk = 0; pk < 2; ++pk)
#pragma unroll
                for (int r = 0; r < 16; ++r) o[pk][r] += el * o2[pk][r];
        }
        bf16_t* zrow = c.ymix() + (tok0 + l) * YP + h * 64; float ss = 0.f;
#pragma unroll
        for (int pk = 0; pk < 2; ++pk)
#pragma unroll
            for (int gq = 0; gq < 4; ++gq) {
                bf16_t* zp = zrow + 32 * pk + 8 * gq + 4 * hi; const u32x2 zz = *(const u32x2*)zp;
                const float y0 = o[pk][4 * gq] * silu_f(bflo(zz[0])), y1 = o[pk][4 * gq + 1] * silu_f(bfhi(zz[0]));
                const float y2 = o[pk][4 * gq + 2] * silu_f(bflo(zz[1])), y3 = o[pk][4 * gq + 3] * silu_f(bfhi(zz[1]));
                u32x2 w = {pk2(y0, y1), pk2(y2, y3)};
                const float r0 = bflo(w[0]), r1 = bfhi(w[0]), r2 = bflo(w[1]), r3 = bfhi(w[1]);
                ss += (r0 * r0 + r1 * r1) + (r2 * r2 + r3 * r3);
                *(u32x2*)(dummy ? c.hb() + (tok0 + l) * HBP + h * 64 + 32 * pk + 8 * gq + 4 * hi : zp) = w;
            }
        ss += __shfl_xor(ss, 32);
        if (hi == 0) c.ssq()[(tok0 + l) * 16 + h] = ss;
        __syncthreads();
      }
    }
}
DI void phase_final(const Ctx& c_in, const float* gain) {
    Ctx c = c_in; { int t_ = c.tid; asm volatile("" : "+v"(t_)); c.tid = t_; c.lane = t_ & 63; }
    const int gt = blockIdx.x * NTHR + c.tid, nt = gridDim.x * NTHR; float* hout = c.h();
    for (int i = gt; i < MTOK * 256; i += nt) {
        const int row = i >> 8, c4 = (i & 255) * 4; const float rs = row_rstd(c.ssp(), row);
        f32x4* p = (f32x4*)(hout + (size_t)row * DM + c4); const f32x4 g = *(const f32x4*)(gain + c4);
        *p = *p * rs * g;
    }
}

constexpr int PH_PER_LAYER = 12, N_PHASES = 2 + 2 * PH_PER_LAYER;
#ifndef PH_MASK
#define PH_MASK 0xffffffffu
#endif
#define KIND(q) (((PH_MASK) >> (q)) & 1u)
#define IN(k) (lo <= (k) && (k) < hi)
DI Ctx launder_ctx(const Ctx& c0) { Ctx c = c0; size_t z = 0; asm volatile("" : "+s"(z)); c.ws = c0.ws + z; return c; }
#define LC() launder_ctx(c0)
DI XcdBarrier make_bar(const Ctx& c0) { XcdBarrier b; size_t z = 0; asm volatile("" : "+s"(z)); unsigned char* w = c0.ws + z; b.bar = (unsigned*)(w + WS_CTL); b.x = xb_xcc_id(); b.st = (volatile LAS unsigned*)(c0.lds + LDS_BAR_OFF); return b; }
#define SEAM(k) do { if (IN(k) && IN((k) + 1)) xcd_barrier(make_bar(c0)); } while (0)
#ifndef PROBE_WC
#define PROBE_WC 1
#endif
#ifndef PROBE_FFNIN
#define PROBE_FFNIN 1
#endif
#ifndef PROBE_D1
#define PROBE_D1 1
#endif
#ifndef PROBE_SEL
#define PROBE_SEL 1
#endif
#ifndef PROBE_ATTN
#define PROBE_ATTN 0
#endif
#ifndef PROBE_S0
#define PROBE_S0 1
#endif
#ifndef PROBE_S1
#define PROBE_S1 1
#endif
#ifndef PROBE_S3
#define PROBE_S3 0
#endif
template <int L> DI void convert_layer(const Ctx& c0, int slots) {
#define LPL(i, stride) (argp(i) + (size_t)L * (stride))
    const Ctx c = LC();
    if (slots & 1) {
        convert_w<1>(LC(), LPL(3, (size_t)DM * NFFIN), DM, NFFIN, c.wb() + WB_1IN, NFFIN, LPL(2, DM), DM, 1.0f);
        convert_w<0>(LC(), LPL(4, (size_t)DFF * DM), DFF, DM, c.wb() + WB_1OUT, DM, nullptr, 0, 0.5f);
        convert_w<2>(LC(), LPL(6, (size_t)DM * DINPROJ), DM, DINPROJ, c.wb() + WB_MIXB, NMIXB, LPL(5, DM), DM, 1.0f);
        convert_w<0>(LC(), LPL(6, (size_t)DM * DINPROJ), DM, DINPROJ, c.wb() + WB_MIXA, NMIXA, LPL(5, DM), DM, 1.0f);
    }
    if (slots & 2) {
        convert_w<0>(LC(), LPL(13, (size_t)2048 * DM), 2048, DM, c.wb() + WB_MO, DM, LPL(12, DM), DM, 1.0f);
        convert_w<1>(LC(), LPL(15, (size_t)DM * NFFIN), DM, NFFIN, c.wb() + WB_2IN, NFFIN, LPL(14, DM), DM, 1.0f);
        convert_w<0>(LC(), LPL(16, (size_t)DFF * DM), DFF, DM, c.wb() + WB_2OUT, DM, nullptr, 0, 0.5f);
    }
#undef LPL
}
template <int layer> DI void layer_phases(const Ctx& c0, const int lo, const int hi) {
    const int G = (int)gridDim.x, bx = (int)blockIdx.x;
    constexpr int pb = 1 + layer * PH_PER_LAYER;
#define LP(i, stride) (argp(i) + (size_t)layer * (stride))
#if PROBE_FFNIN > 1
    if (KIND(2) && IN(pb + 1)) {
        const Ctx c = LC(); pg8::Gemm g{c.hb(), c.wb() + WB_1IN, MTOK, NFFIN, DM, HBP}; pg8::StaticOrder S; S.init(MTOK, NFFIN, G, bx);
#if PROBE_FFNIN == 3
        EpiNull E{(float*)c.ymix()};
        pg8::gemm_phase<EpiNull, pg8::StaticOrder, false>(c.lds, g, S, E, nullptr);
#elif PROBE_FFNIN == 4
        EpiStoreOnly E{c.act()};
        pg8::gemm_phase<EpiStoreOnly, pg8::StaticOrder, false>(c.lds, g, S, E, nullptr);
#else
        EpiSwiGLU E{c.act(), c.ssp(), (LAS float*)(c.lds + RS_LDS_OFF)};
        pg8::gemm_phase<EpiSwiGLU, pg8::StaticOrder, false>(c.lds, g, S, E, nullptr);
#endif
    }
#endif
    if (KIND(2) && IN(pb + 1)) {
        const Ctx c = LC(); pg8::Gemm g{c.hb(), c.wb() + WB_1IN, MTOK, NFFIN, DM, HBP}; pg8::StaticOrder S; S.init(MTOK, NFFIN, G, bx);
        EpiSwiGLU E{c.act(), c.ssp(), (LAS float*)(c.lds + RS_LDS_OFF)};
        pg8::gemm_phase<EpiSwiGLU, pg8::StaticOrder, false>(c.lds, g, S, E, nullptr);
    }
    if (layer == 1 && KIND(1) && IN(pb + 1)) convert_layer<1>(c0, 2);
    SEAM(pb + 1);
    if (KIND(3) && IN(pb + 2)) {
        const Ctx c = LC(); pg8::Gemm g{c.act(), c.wb() + WB_1OUT, MTOK, DM, DFF, ACTP}; pg8::StaticOrder S; S.init(MTOK, DM, G, bx);
#ifdef PROBE_RES
        { EpiResid E0{layer == 0 ? c.x() : c.h(), (float*)c.ymix(), c.hb(), c.ssp(), nullptr, 1}; pg8::gemm_phase<EpiResid, pg8::StaticOrder, false>(c.lds, g, S, E0, nullptr); }
#endif
        EpiResid E{layer == 0 ? c.x() : c.h(), c.h(), c.hb(), c.ssp(), nullptr, 0};
        pg8::gemm_phase<EpiResid, pg8::StaticOrder, false>(c.lds, g, S, E, nullptr);
    }
    SEAM(pb + 2);
    if (KIND(4) && IN(pb + 3)) for (int rep = 0; rep < PROBE_D1; ++rep) {
        const Ctx c = LC(); pg8::Gemm g{c.hb(), c.wb() + WB_MIXB, MTOK, NMIXB, DM, HBP}; pg8::StaticOrder S; S.init(MTOK, NMIXB, G, bx);
        EpiMixB E{c.ssp(), c.ymix(), c.kbuf(), c.vbuf(), c.qi(), c.ki(), c.misc(), c.ropeA(), c.ropeI(), (LAS float*)(c.lds + RS_LDS_OFF)};
        pg8::gemm_phase<EpiMixB, pg8::StaticOrder, false>(c.lds, g, S, E, nullptr);
    }
    SEAM(pb + 3);
    if (KIND(6) && IN(pb + 4)) { if (PROBE_SEL > 1) phase_select(LC()); phase_select(LC()); }
    SEAM(pb + 4);
    if (KIND(7) && IN(pb + 5)) { if (PROBE_ATTN) phase_attn(LC(), 1); phase_attn(LC(), 0); }
    SEAM(pb + 5);
#ifdef PROBE_S0NULL
    if (KIND(5) && IN(pb + 6)) {
        const Ctx c = LC(); pg8::Gemm g{c.hb(), c.wb() + WB_MIXA, MTOK, NMIXA, DM, HBP}; pg8::StaticOrder S; S.init(MTOK, NMIXA, G, bx);
#if PROBE_S0NULL == 1
        EpiNull E{(float*)c.act() + 8 * 1024 * 1024};
        pg8::gemm_phase<EpiNull, pg8::StaticOrder, false>(c.lds, g, S, E, nullptr);
#elif PROBE_S0NULL == 4
        EpiMixA E{c.ssp(), c.ymix(), c.xbc(), (LAS float*)(c.lds + RS_LDS_OFF)};
        pg8::gemm_phase<EpiMixA, pg8::StaticOrder, false>(c.lds, g, S, E, nullptr);
#elif PROBE_S0NULL == 5
        EpiMixAT<false> E{c.ssp(), c.ymix(), c.xbc(), (LAS float*)(c.lds + RS_LDS_OFF)};
        pg8::gemm_phase<EpiMixAT<false>, pg8::StaticOrder, false>(c.lds, g, S, E, nullptr);
#elif PROBE_S0NULL == 2
        EpiMixProbe<false> E{c.xbc()};
        pg8::gemm_phase<EpiMixProbe<false>, pg8::StaticOrder, false>(c.lds, g, S, E, nullptr);
#else
        EpiMixProbe<true> E{c.xbc()};
        pg8::gemm_phase<EpiMixProbe<true>, pg8::StaticOrder, false>(c.lds, g, S, E, nullptr);
#endif
    }
#endif
    if (KIND(5) && IN(pb + 6)) for (int rep = 0; rep < PROBE_S0; ++rep) {
        const Ctx c = LC(); pg8::Gemm g{c.hb(), c.wb() + WB_MIXA, MTOK, NMIXA, DM, HBP}; pg8::StaticOrder S; S.init(MTOK, NMIXA, G, bx);
        EpiMixA E{c.ssp(), c.ymix(), c.xbc(), (LAS float*)(c.lds + RS_LDS_OFF)};
        pg8::gemm_phase<EpiMixA, pg8::StaticOrder, false>(c.lds, g, S, E, nullptr);
    }
    SEAM(pb + 6);
    if (KIND(8) && IN(pb + 7)) { if (PROBE_S1 > 1) phase_ssd_states(LC(), LP(7, 4 * XBCW), LP(8, XBCW), LP(9, 16), LP(10, 16)); phase_ssd_states(LC(), LP(7, 4 * XBCW), LP(8, XBCW), LP(9, 16), LP(10, 16)); if (layer == 0 && KIND(1)) convert_layer<1>(c0, 1); }
    SEAM(pb + 7);
    if (KIND(10) && IN(pb + 8)) { if (PROBE_S3) phase_ssd_out(LC(), LP(7, 4 * XBCW), LP(8, XBCW), LP(9, 16), LP(10, 16), LP(11, 16), 1); phase_ssd_out(LC(), LP(7, 4 * XBCW), LP(8, XBCW), LP(9, 16), LP(10, 16), LP(11, 16), 0); }
    SEAM(pb + 8);
    if (KIND(9) && IN(pb + 9)) {
        const Ctx c = LC(); pg8::Gemm g{c.ymix(), c.wb() + WB_MO, MTOK, DM, 2048, YP}; pg8::StaticOrder S; S.init(MTOK, DM, G, bx);
        EpiResidKS E{c.h(), c.h(), c.hb(), c.ssp(), c.ssq(), 0};
        pg8::gemm_phase<EpiResidKS, pg8::StaticOrder, false>(c.lds, g, S, E, nullptr);
    }
    SEAM(pb + 9);
    if (KIND(2) && IN(pb + 10)) {
        const Ctx c = LC(); pg8::Gemm g{c.hb(), c.wb() + WB_2IN, MTOK, NFFIN, DM, HBP}; pg8::StaticOrder S; S.init(MTOK, NFFIN, G, bx);
        EpiSwiGLU E{c.act(), c.ssp(), (LAS float*)(c.lds + RS_LDS_OFF)};
        pg8::gemm_phase<EpiSwiGLU, pg8::StaticOrder, false>(c.lds, g, S, E, nullptr);
    }
    SEAM(pb + 10);
    if (KIND(3) && IN(pb + 11)) {
        const Ctx c = LC(); pg8::Gemm g{c.act(), c.wb() + WB_2OUT, MTOK, DM, DFF, ACTP}; pg8::StaticOrder S; S.init(MTOK, DM, G, bx);
#ifdef PROBE_RES
        { EpiResid E0{c.h(), (float*)c.ymix(), c.hb(), c.ssp(), nullptr, 1}; pg8::gemm_phase<EpiResid, pg8::StaticOrder, false>(c.lds, g, S, E0, nullptr); }
#endif
        EpiResid E{c.h(), c.h(), c.hb(), c.ssp(), nullptr, 0};
        pg8::gemm_phase<EpiResid, pg8::StaticOrder, false>(c.lds, g, S, E, nullptr);
    }
    SEAM(pb + 11);
}
__global__ void __launch_bounds__(NTHR, 2) mk_fwd(Args args) {
    extern __shared__ __attribute__((aligned(16))) unsigned char lds_raw[];
    Ctx c;
    c.lds = (LAS unsigned char*)lds_raw; c.tid = threadIdx.x; c.lane = c.tid & 63; c.wid = __builtin_amdgcn_readfirstlane(c.tid >> 6);
    unsigned char* ws = args.ws; c.ws = ws;
    const int lo = args.ph_lo, hi = args.ph_hi;
    const bool multi = (hi - lo) > 1;
    if (c.tid == 0) *(LAS u32x4*)(c.lds + LDS_BAR_OFF) = (u32x4){0u, 0u, 0u, 0u};
    __syncthreads();
    if (multi) (void)xcd_barrier_post((unsigned*)(ws + WS_CTL), (volatile LAS unsigned*)(c.lds + LDS_BAR_OFF));
    const Ctx& c0 = c;

    if (KIND(0) && IN(0)) { phase_pro(LC()); if (KIND(1)) convert_layer<0>(c0, 3); } SEAM(0);
#ifdef PROBE_BAR
    if (multi) for (int rep = 0; rep < PROBE_BAR; ++rep) xcd_barrier(make_bar(c0));
#endif
    layer_phases<0>(c0, lo, hi);
    layer_phases<1>(c0, lo, hi);


    if (KIND(12) && IN(N_PHASES - 1)) phase_final(LC(), argp(17));
#undef IN
#undef SEAM
}

#ifndef MK_N_LAUNCHES
#define MK_N_LAUNCHES 1
#endif
extern "C" void kernel_launch(void* const* d_in, const int* in_sizes, int n_in, void* d_out, int out_size, void* d_ws, size_t ws_size, hipStream_t stream) {
    static int grid = 0;
    if (grid == 0) {
        if (n_in != 18 || out_size != MTOK * DM || ws_size < WS_END) { fprintf(stderr, "kernel_launch: unexpected shapes (n_in %d out %d ws %zu need %zu)\n", n_in, out_size, ws_size, (size_t)WS_END); grid = -1; return; }
        int dev = 0, cus = 0, per_cu = 0;
        if (hipGetDevice(&dev) != hipSuccess || hipDeviceGetAttribute(&cus, hipDeviceAttributeMultiprocessorCount, dev) != hipSuccess) { grid = -1; return; }
        if (hipFuncSetAttribute((const void*)mk_fwd, hipFuncAttributeMaxDynamicSharedMemorySize, LDS_BYTES) != hipSuccess) { fprintf(stderr, "kernel_launch: hipFuncSetAttribute failed\n"); grid = -1; return; }
        if (hipOccupancyMaxActiveBlocksPerMultiprocessor(&per_cu, (const void*)mk_fwd, NTHR, LDS_BYTES) != hipSuccess || per_cu < 1) fprintf(stderr, "kernel_launch: occupancy query says %d\n", per_cu);
        (void)hipGetLastError();
        grid = cus;
    }
    if (grid < 0) return;
    (void)hipMemsetAsync((char*)d_ws + WS_CTL, 0, 64 * 1024, stream);
    Args a{};
    for (int i = 0; i < 18; ++i) a.in[i] = (const float*)d_in[i];
    a.out = (float*)d_out; a.ws = (unsigned char*)d_ws;
    for (int f = 0; f < 16; ++f) a.invf[f] = (float)pow(500000.0, -(double)(2 * f) / 32.0);
    for (int f = 0; f < 8; ++f) a.invf[16 + f] = (float)pow(500000.0, -(double)(2 * f) / 16.0);
    if (MK_N_LAUNCHES == 1) {
        a.ph_lo = 0; a.ph_hi = N_PHASES;
        hipLaunchKernelGGL(mk_fwd, dim3(grid), dim3(NTHR), LDS_BYTES, stream, a);
    } else {
        for (int p = 0; p < N_PHASES; ++p) { a.ph_lo = p; a.ph_hi = p + 1; hipLaunchKernelGGL(mk_fwd, dim3(grid), dim3(NTHR), LDS_BYTES, stream, a); }
    }
}
```
